# Optimizing an MI355X kernel written in HIP

```python
import math
import jax
import jax.numpy as jnp
from jax import lax
import numpy as np

D_MODEL = 1024
BATCH = 8
SEQ = 4096
DEPTH = 2

GRID_W = 64
CTX_LEN = 256
QBLOCK = 128
ROPE_THETA = 10000.0
NORM_EPS = 1e-6
N_MOD = 6

MIX_WIDTH = D_MODEL
HEAD_DIM = 64
GQA_HEADS = 8
GQA_KV_HEADS = 2
GQA_GROUP = GQA_HEADS // GQA_KV_HEADS
GQA_WIDTH = GQA_HEADS * HEAD_DIM
DIFF_HEADS = 4
DIFF_QK_DIM = HEAD_DIM // 2
DIFF_V_DIM = HEAD_DIM
DIFF_WIDTH = DIFF_HEADS * DIFF_V_DIM
MLA_HEADS = 4
MLA_Q_RANK = 192
MLA_KV_RANK = 128
MLA_NOPE_DIM = 64
MLA_ROPE_DIM = 32
MLA_V_DIM = 64
MLA_WIDTH = MLA_HEADS * MLA_V_DIM
IN_SPLITS = (GQA_HEADS * HEAD_DIM, GQA_KV_HEADS * HEAD_DIM, GQA_KV_HEADS * HEAD_DIM,
             DIFF_HEADS * 2 * DIFF_QK_DIM, DIFF_HEADS * 2 * DIFF_QK_DIM, DIFF_HEADS * DIFF_V_DIM,
             MLA_Q_RANK, MLA_KV_RANK, MLA_ROPE_DIM)
IN_WIDTH = sum(IN_SPLITS)
D_FF_DENSE = 2816
N_EXPERTS = 8
TOP_K = 2
D_FF_EXPERT = 1792

kernel_name = "hybrid_diffusion_prefix_block"


def _rmsnorm(x, g):
    xf = x.astype(jnp.float32)
    y = xf * lax.rsqrt(jnp.mean(xf * xf, axis=-1, keepdims=True) + NORM_EPS)
    return (y * g.astype(jnp.float32)).astype(x.dtype)


def _modulate(h, shift, scale):
    return h * (1 + scale) + shift


def _split_cols(y):
    out, start = [], 0
    for w in IN_SPLITS:
        out.append(y[..., start:start + w])
        start += w
    return out


def _axial_rope_table(rows, cols, dim):
    quarter = dim // 4
    inv_freq = ROPE_THETA ** (-jnp.arange(quarter, dtype=jnp.float32) / quarter)
    ang = jnp.concatenate([rows[:, None] * inv_freq, cols[:, None] * inv_freq], axis=-1)
    return jnp.cos(ang)[:, None, :], jnp.sin(ang)[:, None, :]


def _rope(x, table):
    cos, sin = table[0].astype(x.dtype), table[1].astype(x.dtype)
    xr = x.reshape(*x.shape[:-1], x.shape[-1] // 2, 2)
    x1, x2 = xr[..., 0], xr[..., 1]
    return jnp.stack([x1 * cos - x2 * sin, x1 * sin + x2 * cos], axis=-1).reshape(x.shape)


def _softmax32(s, scale):
    return jax.nn.softmax(s.astype(jnp.float32) * scale, axis=-1)


def _sweep(fn, *qs):
    B, S = qs[0].shape[:2]
    nb = S // QBLOCK
    blocks = tuple(jnp.moveaxis(q.reshape(B, nb, QBLOCK, *q.shape[2:]), 1, 0) for q in qs)
    out = lax.map(lambda blk: fn(*blk), blocks)
    return jnp.moveaxis(out, 0, 1).reshape(B, S, *out.shape[3:])


def _gqa_attend(k, v):
    scale = HEAD_DIM ** -0.5

    def fn(q):
        p = _softmax32(jnp.einsum('bqhgd,bkhd->bhgqk', q, k), scale).astype(v.dtype)
        return jnp.einsum('bhgqk,bkhd->bqhgd', p, v)
    return fn


def _diff_attend(k, v, lam):
    scale = DIFF_QK_DIM ** -0.5

    def fn(q):
        p = _softmax32(jnp.einsum('bqhjd,bkhjd->bhjqk', q, k), scale)
        a = (p[:, :, 0] - lam * p[:, :, 1]).astype(v.dtype)
        return jnp.einsum('bhqk,bkhd->bqhd', a, v)
    return fn


def _mla_attend(k_nope, k_rope, v):
    scale = (MLA_NOPE_DIM + MLA_ROPE_DIM) ** -0.5

    def fn(q_nope, q_rope):
        s = jnp.einsum('bqhd,bkhd->bhqk', q_nope, k_nope) + jnp.einsum('bqhd,bkd->bhqk', q_rope, k_rope)
        p = _softmax32(s, scale).astype(v.dtype)
        return jnp.einsum('bhqk,bkhd->bqhd', p, v)
    return fn


def _gqa_mixer(lat, ctxp, gq, gk, table, need_ctx):
    q, k, v = lat
    qc, kc, vc = ctxp
    B, S = q.shape[:2]
    C = qc.shape[1]
    q = _rope(_rmsnorm(q.reshape(B, S, GQA_HEADS, HEAD_DIM), gq), table)
    k = _rope(_rmsnorm(k.reshape(B, S, GQA_KV_HEADS, HEAD_DIM), gk), table)
    v = v.reshape(B, S, GQA_KV_HEADS, HEAD_DIM)
    kc = _rmsnorm(kc.reshape(B, C, GQA_KV_HEADS, HEAD_DIM), gk)
    vc = vc.reshape(B, C, GQA_KV_HEADS, HEAD_DIM)
    fn = _gqa_attend(jnp.concatenate([kc, k], axis=1), jnp.concatenate([vc, v], axis=1))
    o = _sweep(fn, q.reshape(B, S, GQA_KV_HEADS, GQA_GROUP, HEAD_DIM)).reshape(B, S, GQA_WIDTH)
    oc = None
    if need_ctx:
        qc = _rmsnorm(qc.reshape(B, C, GQA_HEADS, HEAD_DIM), gq).reshape(B, C, GQA_KV_HEADS, GQA_GROUP, HEAD_DIM)
        oc = _gqa_attend(kc, vc)(qc).reshape(B, C, GQA_WIDTH)
    return o, oc


def _diff_mixer(lat, ctxp, lq1, lk1, lq2, lk2, g_sub, lam_init, table, need_ctx):
    q, k, v = lat
    qc, kc, vc = ctxp
    B, S = q.shape[:2]
    C = qc.shape[1]
    f32 = jnp.float32
    lam = (jnp.exp(jnp.sum(lq1.astype(f32) * lk1.astype(f32)))
           - jnp.exp(jnp.sum(lq2.astype(f32) * lk2.astype(f32))) + lam_init)
    q = _rope(q.reshape(B, S, DIFF_HEADS * 2, DIFF_QK_DIM), table).reshape(B, S, DIFF_HEADS, 2, DIFF_QK_DIM)
    k = _rope(k.reshape(B, S, DIFF_HEADS * 2, DIFF_QK_DIM), table).reshape(B, S, DIFF_HEADS, 2, DIFF_QK_DIM)
    v = v.reshape(B, S, DIFF_HEADS, DIFF_V_DIM)
    kc = kc.reshape(B, C, DIFF_HEADS, 2, DIFF_QK_DIM)
    vc = vc.reshape(B, C, DIFF_HEADS, DIFF_V_DIM)
    fn = _diff_attend(jnp.concatenate([kc, k], axis=1), jnp.concatenate([vc, v], axis=1), lam)
    o = _sweep(fn, q)
    o = (_rmsnorm(o, g_sub) * (1 - lam_init)).reshape(B, S, DIFF_WIDTH)
    oc = None
    if need_ctx:
        oc = _diff_attend(kc, vc, lam)(qc.reshape(B, C, DIFF_HEADS, 2, DIFF_QK_DIM))
        oc = (_rmsnorm(oc, g_sub) * (1 - lam_init)).reshape(B, C, DIFF_WIDTH)
    return o, oc


def _mla_mixer(lat, ctxp, g_cq, g_ckv, w_uq, w_ukv, table, need_ctx):
    cq, ckv, kr = lat
    cqc, ckvc, krc = ctxp
    B, S = cq.shape[:2]
    C = cqc.shape[1]

    def up_q(t):
        y = (_rmsnorm(t, g_cq) @ w_uq).reshape(*t.shape[:2], MLA_HEADS, MLA_NOPE_DIM + MLA_ROPE_DIM)
        return y[..., :MLA_NOPE_DIM], y[..., MLA_NOPE_DIM:]

    def up_kv(t):
        y = (_rmsnorm(t, g_ckv) @ w_ukv).reshape(*t.shape[:2], MLA_HEADS, MLA_NOPE_DIM + MLA_V_DIM)
        return y[..., :MLA_NOPE_DIM], y[..., MLA_NOPE_DIM:]

    qn, qr = up_q(cq)
    qr = _rope(qr, table)
    kn, v = up_kv(ckv)
    kr = _rope(kr[:, :, None, :], table)[:, :, 0]
    knc, vc = up_kv(ckvc)
    fn = _mla_attend(jnp.concatenate([knc, kn], axis=1), jnp.concatenate([krc, kr], axis=1),
                     jnp.concatenate([vc, v], axis=1))
    o = _sweep(fn, qn, qr).reshape(B, S, MLA_WIDTH)
    oc = None
    if need_ctx:
        qnc, qrc = up_q(cqc)
        oc = _mla_attend(knc, krc, vc)(qnc, qrc).reshape(B, C, MLA_WIDTH)
    return o, oc


def _swiglu(h, w_in, w_out):
    gate, up = jnp.split(h @ w_in, 2, axis=-1)
    return (jax.nn.silu(gate) * up) @ w_out


def _moe_swiglu(h, w_router, w_in, w_out):
    logits = (h @ w_router).astype(jnp.float32)
    top_val, top_idx = lax.top_k(logits, TOP_K)
    top_w = jax.nn.softmax(top_val, axis=-1)
    gates = jnp.sum(jax.nn.one_hot(top_idx, N_EXPERTS, dtype=jnp.float32) * top_w[..., None], axis=-2)
    gates = gates.astype(h.dtype)
    out = jnp.zeros_like(h)
    for e in range(N_EXPERTS):
        out = out + gates[..., e:e + 1] * _swiglu(h, w_in[e], w_out[e])
    return out


def setup_inputs(seed: int = 0) -> dict:
    key = jax.random.key(seed)
    ks = jax.random.split(key, 32)
    n_dense = (DEPTH + 1) // 2
    n_moe = DEPTH // 2
    f32 = jnp.float32

    def nrm(k, shape, s):
        return jax.random.normal(k, shape, f32) * s

    def gain(k, shape):
        return 1.0 + 0.1 * jax.random.normal(k, shape, f32)

    return {
        "x": nrm(ks[0], (BATCH, SEQ, D_MODEL), 1.0),
        "c": nrm(ks[1], (BATCH, D_MODEL), 1.0),
        "ctx": nrm(ks[2], (BATCH, CTX_LEN, D_MODEL), 1.0),
        "c_ctx": nrm(ks[3], (D_MODEL,), 1.0),
        "w_mod": nrm(ks[4], (DEPTH, D_MODEL, N_MOD * D_MODEL), 0.5 * D_MODEL ** -0.5),
        "b_mod": nrm(ks[5], (DEPTH, N_MOD * D_MODEL), 0.02),
        "g_attn": gain(ks[6], (DEPTH, D_MODEL)),
        "g_ffn": gain(ks[7], (DEPTH, D_MODEL)),
        "w_in": nrm(ks[8], (DEPTH, D_MODEL, IN_WIDTH), D_MODEL ** -0.5),
        "w_out": nrm(ks[9], (DEPTH, MIX_WIDTH, D_MODEL), MIX_WIDTH ** -0.5),
        "gqa_gq": gain(ks[10], (DEPTH, HEAD_DIM)),
        "gqa_gk": gain(ks[11], (DEPTH, HEAD_DIM)),
        "diff_lq1": nrm(ks[12], (DEPTH, DIFF_QK_DIM), 0.1),
        "diff_lk1": nrm(ks[13], (DEPTH, DIFF_QK_DIM), 0.1),
        "diff_lq2": nrm(ks[14], (DEPTH, DIFF_QK_DIM), 0.1),
        "diff_lk2": nrm(ks[15], (DEPTH, DIFF_QK_DIM), 0.1),
        "diff_gsub": gain(ks[16], (DEPTH, DIFF_V_DIM)),
        "mla_gcq": gain(ks[17], (DEPTH, MLA_Q_RANK)),
        "mla_gckv": gain(ks[18], (DEPTH, MLA_KV_RANK)),
        "mla_wuq": nrm(ks[19], (DEPTH, MLA_Q_RANK, MLA_HEADS * (MLA_NOPE_DIM + MLA_ROPE_DIM)), MLA_Q_RANK ** -0.5),
        "mla_wukv": nrm(ks[20], (DEPTH, MLA_KV_RANK, MLA_HEADS * (MLA_NOPE_DIM + MLA_V_DIM)), MLA_KV_RANK ** -0.5),
        "ffn_w_in": nrm(ks[21], (n_dense, D_MODEL, 2 * D_FF_DENSE), D_MODEL ** -0.5),
        "ffn_w_out": nrm(ks[22], (n_dense, D_FF_DENSE, D_MODEL), D_FF_DENSE ** -0.5),
        "moe_router": nrm(ks[23], (n_moe, D_MODEL, N_EXPERTS), D_MODEL ** -0.5),
        "moe_w_in": nrm(ks[24], (n_moe, N_EXPERTS, D_MODEL, 2 * D_FF_EXPERT), D_MODEL ** -0.5),
        "moe_w_out": nrm(ks[25], (n_moe, N_EXPERTS, D_FF_EXPERT, D_MODEL), D_FF_EXPERT ** -0.5),
        "g_final": gain(ks[26], (D_MODEL,)),
    }


def reference(x, c, ctx, c_ctx, w_mod, b_mod, g_attn, g_ffn, w_in, w_out, gqa_gq, gqa_gk,
              diff_lq1, diff_lk1, diff_lq2, diff_lk2, diff_gsub, mla_gcq, mla_gckv, mla_wuq, mla_wukv,
              ffn_w_in, ffn_w_out, moe_router, moe_w_in, moe_w_out, g_final):
    B, S, D = x.shape
    ROWS = S // GRID_W
    t = jnp.arange(ROWS * GRID_W)
    rows = (t // GRID_W).astype(jnp.float32)
    cols = (t % GRID_W).astype(jnp.float32)
    table_a = _axial_rope_table(rows, cols, HEAD_DIM)
    table_b = _axial_rope_table(rows, cols, DIFF_QK_DIM)
    table_c = _axial_rope_table(rows, cols, MLA_ROPE_DIM)
    sc = jax.nn.silu(c)
    scc = jax.nn.silu(c_ctx)
    xc = ctx
    for l in range(DEPTH):
        need_ctx = l < DEPTH - 1
        mod = (sc @ w_mod[l] + b_mod[l]).reshape(B, N_MOD, 1, D)
        modc = (scc @ w_mod[l] + b_mod[l]).reshape(N_MOD, D)
        h = _modulate(_rmsnorm(x, g_attn[l]), mod[:, 0], mod[:, 1])
        hc = _modulate(_rmsnorm(xc, g_attn[l]), modc[0], modc[1])
        p = _split_cols(h @ w_in[l])
        pc = _split_cols(hc @ w_in[l])
        oa, oac = _gqa_mixer(p[0:3], pc[0:3], gqa_gq[l], gqa_gk[l], table_a, need_ctx)
        ob, obc = _diff_mixer(p[3:6], pc[3:6], diff_lq1[l], diff_lk1[l], diff_lq2[l], diff_lk2[l],
                              diff_gsub[l], 0.8 - 0.6 * math.exp(-0.3 * l), table_b, need_ctx)
        om, omc = _mla_mixer(p[6:9], pc[6:9], mla_gcq[l], mla_gckv[l], mla_wuq[l], mla_wukv[l],
                             table_c, need_ctx)
        x = x + mod[:, 2] * (jnp.concatenate([oa, ob, om], axis=-1) @ w_out[l])
        if need_ctx:
            xc = xc + modc[2] * (jnp.concatenate([oac, obc, omc], axis=-1) @ w_out[l])
        if l % 2 == 0:
            wi, wo = ffn_w_in[l // 2], ffn_w_out[l // 2]
            ffn = lambda u: _swiglu(u, wi, wo)
        else:
            wr, wi, wo = moe_router[l // 2], moe_w_in[l // 2], moe_w_out[l // 2]
            ffn = lambda u: _moe_swiglu(u, wr, wi, wo)
        h2 = _modulate(_rmsnorm(x, g_ffn[l]), mod[:, 3], mod[:, 4])
        x = x + mod[:, 5] * ffn(h2)
        if need_ctx:
            h2c = _modulate(_rmsnorm(xc, g_ffn[l]), modc[3], modc[4])
            xc = xc + modc[5] * ffn(h2c)
    return _rmsnorm(x, g_final)
```

```cpp
#include <hip/hip_runtime.h>
#include <hip/hip_bf16.h>
#include <cstdio>
#include <cstdint>

#define LAS __attribute__((address_space(3)))
#define GAS __attribute__((address_space(1)))
typedef unsigned short bf16_t;
typedef short bf16x8 __attribute__((ext_vector_type(8)));
typedef short s16x4 __attribute__((ext_vector_type(4)));
typedef float f32x4 __attribute__((ext_vector_type(4)));
typedef float f32x2 __attribute__((ext_vector_type(2)));
typedef float f32x16 __attribute__((ext_vector_type(16)));
typedef unsigned u32x4 __attribute__((ext_vector_type(4)));
typedef unsigned u32x2 __attribute__((ext_vector_type(2)));
typedef __bf16 bf16x2_t __attribute__((ext_vector_type(2)));

constexpr int NB = 8, SEQ = 4096, CTX = 256, TROWS = SEQ + CTX  , MROWS = NB * TROWS  , DM = 1024;
constexpr int TPB = TROWS / 256;
constexpr int NTOK = NB * SEQ;
constexpr int INW = 1888, PW = 1920;
constexpr int DFF = 2816, DFE = 1792, NEXP = 8;
constexpr float NEPS = 1e-6f;
constexpr int PC_GQ = 0, PC_GK = 512, PC_GV = 640, PC_DQ = 768, PC_DK = 1024, PC_DV = 1280, PC_CQ = 1536, PC_CKV = 1728, PC_KR = 1856;
constexpr float SC_G = 0.18033688011112042f;
constexpr float SC_D = 0.25503486164919736f;
constexpr float SC_M = 0.14724444602590306f;

__device__ __forceinline__ unsigned cvtpk(float lo, float hi) { f32x2 v = {lo, hi}; bf16x2_t b = __builtin_convertvector(v, bf16x2_t); return __builtin_bit_cast(unsigned, b); }
__device__ __forceinline__ float bflo(unsigned u) { return __builtin_bit_cast(float, u << 16); }
__device__ __forceinline__ float bfhi(unsigned u) { return __builtin_bit_cast(float, u & 0xffff0000u); }
__device__ __forceinline__ unsigned cvt4_fp8(float a, float b, float c, float d) {
    a = __builtin_amdgcn_fmed3f(a, -448.0f, 448.0f); b = __builtin_amdgcn_fmed3f(b, -448.0f, 448.0f); c = __builtin_amdgcn_fmed3f(c, -448.0f, 448.0f); d = __builtin_amdgcn_fmed3f(d, -448.0f, 448.0f);
    unsigned r = (unsigned)__builtin_amdgcn_cvt_pk_fp8_f32(a, b, 0, false); return (unsigned)__builtin_amdgcn_cvt_pk_fp8_f32(c, d, (int)r, true); }
constexpr float W8_SCALE = 64.0f;
constexpr float W8_INV = 1.0f / 64.0f;
typedef int i32x4 __attribute__((ext_vector_type(4)));
typedef int i32x8 __attribute__((ext_vector_type(8)));

namespace pg8 {
constexpr int BM = 256, BK = 64, HALF = 128, HTB = HALF * BK * 2, STAGE_BYTES = 8 * HTB, NXCD = 8, WGM = 8;
__host__ __device__ __forceinline__ int lds_byte(int r, int c) { const int st = (r >> 4) * 2 + (c >> 5), rr = r & 15, cc = c & 31, ob = rr * 64 + cc * 2; return st * 1024 + (ob ^ (((ob >> 9) & 1) << 5)); }
__host__ __device__ __forceinline__ void stage_rc(int b, int& R, int& C) { const int st = b / 1024, sb = b % 1024, swz = sb ^ (((sb >> 9) & 1) << 5); R = (st >> 1) * 16 + swz / 64; C = (st & 1) * 32 + (swz % 64) / 2; }
__host__ __device__ __forceinline__ int perm32(int rho) { const int n = rho >> 4, i = rho & 15; return 8 * (i >> 2) + 4 * n + (i & 3); }
struct Unit { int pm, pn; int hh = 0; };
struct Gemm { const bf16_t* A; const bf16_t* Bt; int lda; int K; };
struct StaticOrder {
    int nM, nN, nwg, G, c;
    __device__ void init(int nM_, int nN_, int G_, int c_) { nM = nM_; nN = nN_; nwg = nM * nN; G = G_; c = c_; }
    __device__ bool next(int i, Unit& u) const {
        const long L = (long)i * G + c; if (L >= nwg) return false;
        int wgid = (int)L; { const int q = nwg / NXCD, r = nwg % NXCD, xcd = wgid % NXCD, off = wgid / NXCD; wgid = (xcd < r ? xcd * (q + 1) : r * (q + 1) + (xcd - r) * q) + off; }
        const int nig = WGM * nN, gid = wgid / nig, fm = gid * WGM, gsz = (nM - fm) < WGM ? (nM - fm) : WGM;
        u.pm = fm + ((wgid % nig) % gsz); u.pn = (wgid % nig) / gsz; return true;
    }
    __device__ void decode_plain(int wgid, Unit& u) const { const int nig = WGM * nN, gid = wgid / nig, fm = gid * WGM, gsz = (nM - fm) < WGM ? (nM - fm) : WGM; u.pm = fm + ((wgid % nig) % gsz); u.pn = (wgid % nig) / gsz; }
};
template <int MODE> struct MapOrder {
    StaticOrder so; int t0, nct; const int* tile_e;
    __device__ bool next(int i, Unit& u) const {
        if (!so.next(i, u)) return false;
        if (MODE == 1) { u.pm = u.pm + u.pm / 16 + 1; }
        if (MODE == 2) { const int e = tile_e[t0 + u.pm]; u.pm = t0 + u.pm; u.pn = e * nct + u.pn; }
        if (MODE == 3) { const int e = tile_e[t0 + u.pm]; u.pn = e * nct + u.pn; }
        return true;
    }
};
struct MoeTailOrder {
    StaticOrder so; int nfull, ntot, c, nct; const int* tile_e;
    __device__ bool next(int i, Unit& u) const { const int j = c; if (i > 0 || nfull + j / 2 >= ntot) return false; so.decode_plain(nfull + j / 2, u); u.hh = j & 1; const int e = tile_e[u.pm]; u.pn = e * nct + u.pn; return true; }
};
struct TailOrder {
    int nU, stride, k, pn; bool on;
    __device__ void init(int nU_, int pn_, int G_, int c_, int nfull) { nU = nU_; pn = pn_; const int r = nfull % G_, idle = r ? G_ - r : 0;
        if (idle > 0 && idle * 2 >= nU_) { on = c_ >= r; stride = idle; k = c_ - r; } else { on = true; stride = G_; k = c_; } }
    __device__ bool next(int i, Unit& u) const { const int L = k + i * stride; if (!on || L >= nU) return false; u.pm = L; u.pn = pn; return true; }
};
struct RotOrder {
    int nM, nN, pn0, G, k;
    __device__ void init(int nM_, int nN_, int pn0_, int G_, int c_, int rot) { nM = nM_; nN = nN_; pn0 = pn0_; G = G_; k = ((c_ - rot) % G_ + G_) % G_; }
    __device__ bool next(int i, Unit& u) const { const int L = k + i * G; if (L >= nM * nN) return false; u.pm = L / nN; u.pn = pn0 + L % nN; return true; }
};
struct CtxOrder {
    int c, mul;
    __device__ bool next(int i, Unit& u) const { if (i > 0 || c >= 32) return false; u.pm = (c & 7) * mul; u.pn = c >> 3; return true; }
};
template <class Epi, class Sched, bool ALIGN_EPI, int ESZ = 2, bool HN = false>
__device__ __forceinline__ void gemm_phase(LAS unsigned char* lds, const Gemm g, const Sched& S, const Epi& E) {
    int tid_ = threadIdx.x; asm volatile("" : "+v"(tid_));
    const int tid = tid_, wid = __builtin_amdgcn_readfirstlane(tid >> 6), lane = tid & 63, wr = wid >> 2, wc = wid & 3, fr = lane & 15, fq = lane >> 4;
    const int K = g.K, nt = K * ESZ / (BK * 2), lda = g.lda;
    unsigned voffA[2], voffB[2];
#pragma unroll
    for (int i = 0; i < 2; ++i) { int R, C; stage_rc(tid * 16 + i * 8192, R, C); const int Rb = Epi::PERM ? ((R & ~31) + perm32(R & 31)) : R;
        voffA[i] = (unsigned)(R * lda * ESZ + C * 2); voffB[i] = (unsigned)(Rb * K * ESZ + C * 2); }
    const size_t kstep = (size_t)(BK * 2);
    const size_t hstepA = (size_t)HALF * lda * ESZ, hstepB = (size_t)HALF * K * ESZ;
    const size_t tstepA = 2 * hstepA, tstepB = 2 * hstepB;
    const unsigned ldsw = (unsigned)wid * 1024u;
    const int aoff = lds_byte(wr * 64 + fr, fq * 8), boff = lds_byte(wc * 32 + fr, fq * 8);
#define PG8_SA(b, h) (((b) * 2 + (h)) * HTB)
#define PG8_SB(b, h) ((4 + (b) * 2 + (h)) * HTB)
#define PG8_STAGE(bufoff, gbase, voff) do { _Pragma("unroll") for (int _i = 0; _i < 2; ++_i) \
        __builtin_amdgcn_global_load_lds((const unsigned*)((const char*)(gbase) + (voff)[_i]), (LAS unsigned*)(lds + (bufoff) + ldsw + _i * 8192), 16, 0, 0); } while (0)
#define PG8_LD8(p_) __builtin_shufflevector(*(const LAS i32x4*)(p_), *(const LAS i32x4*)((p_) + 1024), 0, 1, 2, 3, 4, 5, 6, 7)
#define PG8_LDA(dst, b, h) do { if constexpr (ESZ == 2) { _Pragma("unroll") for (int m = 0; m < 4; ++m) _Pragma("unroll") for (int k = 0; k < 2; ++k) dst[m][k] = *(const LAS bf16x8*)(lds + PG8_SA(b, h) + aoff + m * 2048 + k * 1024); } \
        else { _Pragma("unroll") for (int m = 0; m < 4; ++m) dst##8[m] = PG8_LD8(lds + PG8_SA(b, h) + aoff + m * 2048); } } while (0)
#define PG8_LDB(dst, b, h) do { if constexpr (ESZ == 2) { _Pragma("unroll") for (int n = 0; n < 2; ++n) _Pragma("unroll") for (int k = 0; k < 2; ++k) dst[n][k] = *(const LAS bf16x8*)(lds + PG8_SB(b, h) + boff + n * 2048 + k * 1024); } \
        else { _Pragma("unroll") for (int n = 0; n < 2; ++n) dst##8[n] = PG8_LD8(lds + PG8_SB(b, h) + boff + n * 2048); } } while (0)
#define PG8_CAT(x0, x1) __builtin_shufflevector(__builtin_bit_cast(i32x4, x0), __builtin_bit_cast(i32x4, x1), 0, 1, 2, 3, 4, 5, 6, 7)
#define PG8_MMA(ai, bj, At, Bt) do { __builtin_amdgcn_s_setprio(1); _Pragma("unroll") for (int m = 0; m < 4; ++m) _Pragma("unroll") for (int n = 0; n < 2; ++n) { \
        if constexpr (ESZ == 2) { _Pragma("unroll") for (int k = 0; k < 2; ++k) acc[ai][bj][m][n] = __builtin_amdgcn_mfma_f32_16x16x32_bf16(Bt[n][k], At[m][k], acc[ai][bj][m][n], 0, 0, 0); } \
        else { asm volatile("v_mfma_f32_16x16x128_f8f6f4 %0, %1, %2, %0" : "+v"(acc[ai][bj][m][n]) : "v"(Bt##8[n]), "v"(At##8[m])); } } \
        __builtin_amdgcn_s_setprio(0); } while (0)
#define PG8_WAIT_V(n) asm volatile("s_waitcnt vmcnt(" #n ")" ::: "memory")
#define PG8_WAIT_L(n) asm volatile("s_waitcnt lgkmcnt(" #n ")" ::: "memory")
#define PG8_BAR __builtin_amdgcn_s_barrier()
#define PG8_SCHED __builtin_amdgcn_sched_barrier(0)
    Unit cur, nxt; int ui = 0;
    if (!S.next(0, cur)) return;
    f32x4 acc[2][2][4][2];
#pragma unroll
    for (int a = 0; a < 2; ++a)
#pragma unroll
        for (int b = 0; b < 2; ++b)
#pragma unroll
            for (int m = 0; m < 4; ++m)
#pragma unroll
                for (int n = 0; n < 2; ++n) acc[a][b][m][n] = (f32x4){0.f, 0.f, 0.f, 0.f};
    bf16x8 At[4][2], B0[2][2], B1[2][2]; i32x8 At8[4], B08[2], B18[2];
    const char* cA = (const char*)g.A + (size_t)cur.pm * tstepA; const char* cB = (const char*)g.Bt + (size_t)cur.pn * tstepB + (size_t)cur.hh * hstepB;
    PG8_STAGE(PG8_SB(0, 0), cB, voffB); PG8_STAGE(PG8_SB(0, 1), cB + hstepB, voffB); PG8_STAGE(PG8_SA(0, 0), cA, voffA); PG8_STAGE(PG8_SA(0, 1), cA + hstepA, voffA);
    if (wr == 1) PG8_BAR;
    PG8_WAIT_V(2); PG8_BAR;
    PG8_STAGE(PG8_SB(1, 0), cB + kstep, voffB); PG8_STAGE(PG8_SA(1, 0), cA + kstep, voffA); PG8_STAGE(PG8_SB(1, 1), cB + hstepB + kstep, voffB);
    PG8_WAIT_V(6); PG8_BAR;
    for (;;) {
        const bool has_next = S.next(ui + 1, nxt);
        const char* nA = has_next ? (const char*)g.A + (size_t)nxt.pm * tstepA : cA; const char* nB = has_next ? (const char*)g.Bt + (size_t)nxt.pn * tstepB + (size_t)nxt.hh * hstepB : cB;
#pragma nounroll
        for (int t = 0; t < nt; t += 2) {
            const bool last = (t == nt - 2);
            const char* a1 = cA + (size_t)(t + 1) * kstep;
            const char* a2 = last ? nA : cA + (size_t)(t + 2) * kstep; const char* b2 = last ? nB : cB + (size_t)(t + 2) * kstep;
            const char* a3 = a2 + kstep; const char* b3 = b2 + kstep;
            PG8_LDB(B0, 0, 0); if constexpr (!HN) PG8_LDB(B1, 0, 1); PG8_SCHED; PG8_LDA(At, 0, 0); PG8_STAGE(PG8_SA(1, 1), a1 + hstepA, voffA);
            PG8_WAIT_V(8); PG8_WAIT_L(0); PG8_BAR; PG8_MMA(0, 0, At, B0); if constexpr (!HN) PG8_MMA(0, 1, At, B1); PG8_BAR; PG8_SCHED;
            PG8_LDA(At, 0, 1); PG8_STAGE(PG8_SB(0, 0), b2, voffB); PG8_STAGE(PG8_SB(0, 1), b2 + hstepB, voffB); PG8_STAGE(PG8_SA(0, 0), a2, voffA);
            PG8_WAIT_V(8); PG8_WAIT_L(0); PG8_BAR; PG8_MMA(1, 0, At, B0); if constexpr (!HN) PG8_MMA(1, 1, At, B1); PG8_BAR; PG8_SCHED;
            PG8_LDB(B0, 1, 0); if constexpr (!HN) PG8_LDB(B1, 1, 1); PG8_SCHED; PG8_LDA(At, 1, 0); PG8_STAGE(PG8_SA(0, 1), a2 + hstepA, voffA);
            PG8_WAIT_V(8); PG8_WAIT_L(0); PG8_BAR; PG8_MMA(0, 0, At, B0); if constexpr (!HN) PG8_MMA(0, 1, At, B1); PG8_BAR; PG8_SCHED;
            PG8_LDA(At, 1, 1); PG8_STAGE(PG8_SB(1, 0), b3, voffB); PG8_STAGE(PG8_SB(1, 1), b3 + hstepB, voffB); PG8_STAGE(PG8_SA(1, 0), a3, voffA);
            PG8_WAIT_V(8); PG8_WAIT_L(0); PG8_BAR; PG8_MMA(1, 0, At, B0); if constexpr (!HN) PG8_MMA(1, 1, At, B1); PG8_BAR; PG8_SCHED;
        }
        if constexpr (ALIGN_EPI) { if (wr == 0) PG8_BAR; }
        if constexpr (ESZ == 1) {
            asm volatile("s_nop 15\n\ts_nop 7" : "+v"(acc[1][1][0][0]), "+v"(acc[1][1][0][1]), "+v"(acc[1][1][1][0]), "+v"(acc[1][1][1][1]), "+v"(acc[1][1][2][0]), "+v"(acc[1][1][2][1]), "+v"(acc[1][1][3][0]), "+v"(acc[1][1][3][1])); }
        { int t2 = threadIdx.x; asm volatile("" : "+v"(t2)); const int l2 = t2 & 63; E(acc, cur, wr, wc, l2 & 15, l2 >> 4); }
        if (!has_next) break;
#pragma unroll
        for (int a = 0; a < 2; ++a)
#pragma unroll
            for (int b = 0; b < 2; ++b)
#pragma unroll
                for (int m = 0; m < 4; ++m)
#pragma unroll
                    for (int n = 0; n < 2; ++n) acc[a][b][m][n] = (f32x4){0.f, 0.f, 0.f, 0.f};
        cur = nxt; cA = nA; cB = nB; ++ui;
        if constexpr (ALIGN_EPI) { if (wr == 1) PG8_BAR; }
    }
    PG8_WAIT_V(0);
    if constexpr (!ALIGN_EPI) { if (wr == 0) PG8_BAR; }
    PG8_BAR;
#undef PG8_SA
#undef PG8_SB
#undef PG8_STAGE
#undef PG8_LDA
#undef PG8_LD8
#undef PG8_LDB
#undef PG8_MMA
#undef PG8_CAT
#undef PG8_WAIT_V
#undef PG8_WAIT_L
#undef PG8_BAR
#undef PG8_SCHED
}

__device__ __forceinline__ u32x4 pack8(const f32x4 a, const f32x4 b) { u32x4 w; w.x = cvtpk(a[0], a[1]); w.y = cvtpk(a[2], a[3]); w.z = cvtpk(b[0], b[1]); w.w = cvtpk(b[2], b[3]); return w; }
struct EpiBf16 {
    static constexpr bool PERM = true;
    bf16_t* O; int ldc, ncols, nct, row_add; float accscale;
    __device__ __forceinline__ void operator()(const f32x4 (&acc)[2][2][4][2], const Unit& u, int wr, int wc, int fr, int fq) const {
        const int row0 = (u.pm + row_add) * BM + wr * 64 + fr; const int colt = (u.pn % nct) * BM + wc * 32 + 8 * fq;
#pragma unroll
        for (int bj = 0; bj < 2; ++bj) { const int col0 = colt + bj * HALF; if (col0 < ncols) {
#pragma unroll
            for (int ai = 0; ai < 2; ++ai)
#pragma unroll
                for (int m = 0; m < 4; ++m) __builtin_nontemporal_store(pack8(acc[ai][bj][m][0] * accscale, acc[ai][bj][m][1] * accscale), (u32x4*)(O + (size_t)(row0 + ai * HALF + m * 16) * ldc + col0)); } }
    }
};
struct EpiBf16H {
    static constexpr bool PERM = true;
    bf16_t* O; int ldc, nct, row_add; float accscale;
    __device__ __forceinline__ void operator()(const f32x4 (&acc)[2][2][4][2], const Unit& u, int wr, int wc, int fr, int fq) const {
        const int row0 = (u.pm + row_add) * BM + wr * 64 + fr; const int col0 = (u.pn % nct) * BM + u.hh * HALF + wc * 32 + 8 * fq;
#pragma unroll
        for (int ai = 0; ai < 2; ++ai)
#pragma unroll
            for (int m = 0; m < 4; ++m) __builtin_nontemporal_store(pack8(acc[ai][0][m][0] * accscale, acc[ai][0][m][1] * accscale), (u32x4*)(O + (size_t)(row0 + ai * HALF + m * 16) * ldc + col0));
    }
};
template <bool OUT8, bool IN8 = OUT8> struct EpiSwiglu {
    static constexpr bool PERM = true;
    void* O; int ldc, nct, row_sub;
    __device__ __forceinline__ void operator()(const f32x4 (&acc)[2][2][4][2], const Unit& u, int wr, int wc, int fr, int fq) const {
        const int row0 = (u.pm - row_sub) * BM + wr * 64 + fr; const int col0 = (u.pn % nct) * HALF + wc * 32 + 8 * fq;
#pragma unroll
        for (int ai = 0; ai < 2; ++ai)
#pragma unroll
            for (int m = 0; m < 4; ++m) { f32x4 r[2];
#pragma unroll
                for (int n = 0; n < 2; ++n) { const f32x4 gt = acc[ai][0][m][n], up = acc[ai][1][m][n];
                    constexpr float ES = IN8 ? -1.4426950408889634f * W8_INV : -1.4426950408889634f, DS = IN8 ? 4096.0f : 1.0f;
                    const f32x4 gu = gt * up;
#pragma unroll
                    for (int j = 0; j < 4; ++j) { const float e = __builtin_amdgcn_exp2f(gt[j] * ES); r[n][j] = gu[j] * __builtin_amdgcn_rcpf(__builtin_fmaf(e, DS, DS)); } }
                const size_t off = (size_t)(row0 + ai * HALF + m * 16) * ldc + col0;
                if constexpr (OUT8) { u32x2 w; w.x = cvt4_fp8(r[0][0], r[0][1], r[0][2], r[0][3]); w.y = cvt4_fp8(r[1][0], r[1][1], r[1][2], r[1][3]); *(u32x2*)((unsigned char*)O + off) = w; }
                else *(u32x4*)((bf16_t*)O + off) = pack8(r[0], r[1]); }
    }
};
template <bool UNI> struct EpiRes {
    static constexpr bool PERM = true;
    const float* xin; const float* cin; bf16_t* xw; const float* modl; int which; float accscale; int pm_mul;
    __device__ __forceinline__ void operator()(const f32x4 (&acc)[2][2][4][2], const Unit& u, int wr, int wc, int fr, int fq) const {
        const int pme = u.pm * pm_mul; const int b = pme / TPB, jt = pme % TPB;
        bf16_t* out = xw + (size_t)pme * BM * DM;
        const float* basef = (jt == 0 ? cin + (size_t)b * CTX * DM : xin + ((size_t)b * SEQ + (size_t)(jt - 1) * BM) * DM);
        const float* gate = modl + (size_t)((jt == 0 ? 8 : b) * 6 + which) * DM;
        const int col0 = u.pn * BM + wc * 32 + 8 * fq;
        f32x4 gv[2][2];
#pragma unroll
        for (int bj = 0; bj < 2; ++bj)
#pragma unroll
            for (int n = 0; n < 2; ++n) gv[bj][n] = *(const f32x4*)(gate + col0 + bj * HALF + 4 * n) * accscale;
#pragma unroll
        for (int ai = 0; ai < 2; ++ai) {
            if constexpr (UNI) { u32x4 bs[4][2];
#pragma unroll
                for (int m = 0; m < 4; ++m)
#pragma unroll
                    for (int bj = 0; bj < 2; ++bj) bs[m][bj] = __builtin_nontemporal_load((const u32x4*)(out + (size_t)(ai * HALF + wr * 64 + m * 16 + fr) * DM + col0 + bj * HALF));
#pragma unroll
                for (int m = 0; m < 4; ++m)
#pragma unroll
                    for (int bj = 0; bj < 2; ++bj) { const u32x4 w = bs[m][bj];
                        const f32x4 b0 = (f32x4){bflo(w.x), bfhi(w.x), bflo(w.y), bfhi(w.y)}, b1 = (f32x4){bflo(w.z), bfhi(w.z), bflo(w.w), bfhi(w.w)};
                        *(u32x4*)(out + (size_t)(ai * HALF + wr * 64 + m * 16 + fr) * DM + col0 + bj * HALF) = pack8(b0 + gv[bj][0] * acc[ai][bj][m][0], b1 + gv[bj][1] * acc[ai][bj][m][1]); }
            } else { f32x4 bs[4][2][2];
#pragma unroll
                for (int m = 0; m < 4; ++m)
#pragma unroll
                    for (int bj = 0; bj < 2; ++bj)
#pragma unroll
                        for (int n = 0; n < 2; ++n) bs[m][bj][n] = __builtin_nontemporal_load((const f32x4*)(basef + (size_t)(ai * HALF + wr * 64 + m * 16 + fr) * DM + col0 + bj * HALF + 4 * n));
#pragma unroll
                for (int m = 0; m < 4; ++m)
#pragma unroll
                    for (int bj = 0; bj < 2; ++bj)
                        *(u32x4*)(out + (size_t)(ai * HALF + wr * 64 + m * 16 + fr) * DM + col0 + bj * HALF) = pack8(bs[m][bj][0] + gv[bj][0] * acc[ai][bj][m][0], bs[m][bj][1] + gv[bj][1] * acc[ai][bj][m][1]);
            }
        }
    }
};
struct EpiMla {
    static constexpr bool PERM = true;
    bf16_t* QM; bf16_t* KN; bf16_t* VM; const float* MS; LAS float* bslot; int cbase, cend;
    __device__ __forceinline__ void operator()(const f32x4 (&acc)[2][2][4][2], const Unit& u, int wr, int wc, int fr, int fq) const {
        const int row0 = u.pm * BM + wr * 64 + fr;
#pragma unroll
        for (int bj = 0; bj < 2; ++bj) { const int cb = cbase + u.pn * BM + bj * HALF + wc * 32;
            if (cb < cend) { bf16_t* dst; int ld; float sc; int which = -1;
                if (cb < 384) { dst = QM + cb; ld = 384; sc = SC_M; which = 0; }
                else { const int cc = cb - 384, hd = cc >> 7, d = cc & 127; dst = (d < 64 ? KN + hd * 64 + d : VM + hd * 64 + (d - 64)); ld = 256; sc = 1.0f; if (d < 64) which = 1; }
                float rmax = 0.f;
                float rs[2][4];
#pragma unroll
                for (int ai = 0; ai < 2; ++ai)
#pragma unroll
                    for (int m = 0; m < 4; ++m) { const float* ms = MS + (size_t)(row0 + ai * HALF + m * 16) * 16;
                        if (cb < 384) { const f32x4 s4 = *(const f32x4*)ms; const f32x2 s2 = *(const f32x2*)(ms + 4); rs[ai][m] = ((s4[0] + s4[1]) + (s4[2] + s4[3])) + (s2[0] + s2[1]); }
                        else { const f32x4 s4 = *(const f32x4*)(ms + 8); rs[ai][m] = (s4[0] + s4[1]) + (s4[2] + s4[3]); } }
#pragma unroll
                for (int ai = 0; ai < 2; ++ai)
#pragma unroll
                    for (int m = 0; m < 4; ++m) { const int row = row0 + ai * HALF + m * 16; const float scr_ = sc * __builtin_amdgcn_rsqf(rs[ai][m] * (cb < 384 ? 1.f / 192.f : 1.f / 128.f) + NEPS);
                        const f32x4 a = acc[ai][bj][m][0] * scr_, c = acc[ai][bj][m][1] * scr_;
                        *(u32x4*)(dst + (size_t)row * ld + 8 * fq) = pack8(a, c);
                        float sq = ((a[0] * a[0] + a[1] * a[1]) + (a[2] * a[2] + a[3] * a[3])) + ((c[0] * c[0] + c[1] * c[1]) + (c[2] * c[2] + c[3] * c[3]));
                        sq += __builtin_bit_cast(float, __builtin_amdgcn_ds_swizzle(__builtin_bit_cast(int, sq), (16 << 10) | 0x1f));
                        { auto rr = __builtin_amdgcn_permlane32_swap(__float_as_uint(sq), __float_as_uint(sq), false, false); sq = __uint_as_float(rr[0]) + __uint_as_float(rr[1]); }
                        rmax = fmaxf(rmax, sq); }
                if (which >= 0) {
                    rmax = fmaxf(rmax, __builtin_bit_cast(float, __builtin_amdgcn_ds_swizzle(__builtin_bit_cast(int, rmax), (1 << 10) | 0x1f))); rmax = fmaxf(rmax, __builtin_bit_cast(float, __builtin_amdgcn_ds_swizzle(__builtin_bit_cast(int, rmax), (2 << 10) | 0x1f)));
                    rmax = fmaxf(rmax, __builtin_bit_cast(float, __builtin_amdgcn_ds_swizzle(__builtin_bit_cast(int, rmax), (4 << 10) | 0x1f))); rmax = fmaxf(rmax, __builtin_bit_cast(float, __builtin_amdgcn_ds_swizzle(__builtin_bit_cast(int, rmax), (8 << 10) | 0x1f)));
                    if (fr == 0 && fq == 0) { LAS float* p = bslot + (wr * 4 + wc) * 2 + which; *p = fmaxf(*p, rmax); } }
            }
        }
    }
};
__device__ __forceinline__ float quad_sum(float s) {
    s += __builtin_bit_cast(float, __builtin_amdgcn_ds_swizzle(__builtin_bit_cast(int, s), (16 << 10) | 0x1f));
    auto rr = __builtin_amdgcn_permlane32_swap(__float_as_uint(s), __float_as_uint(s), false, false); return __uint_as_float(rr[0]) + __uint_as_float(rr[1]); }
__device__ __forceinline__ float dot4(const f32x4 a) { return (a[0] * a[0] + a[1] * a[1]) + (a[2] * a[2] + a[3] * a[3]); }
__device__ __forceinline__ void rot8(f32x4& a, f32x4& c, const f32x4 t0, const f32x4 t1) {
    const f32x4 a_ = a, c_ = c;
    a[0] = a_[0] * t0[0] - a_[1] * t0[1]; a[1] = a_[0] * t0[1] + a_[1] * t0[0]; a[2] = a_[2] * t0[2] - a_[3] * t0[3]; a[3] = a_[2] * t0[3] + a_[3] * t0[2];
    c[0] = c_[0] * t1[0] - c_[1] * t1[1]; c[1] = c_[0] * t1[1] + c_[1] * t1[0]; c[2] = c_[2] * t1[2] - c_[3] * t1[3]; c[3] = c_[2] * t1[3] + c_[3] * t1[2]; }
struct EpiIn {
    static constexpr bool PERM = true;
    bf16_t* P; float* MS; const f32x2* ropeA; const f32x2* ropeB; const float* gq; const float* gk; LAS float* bslot; bf16_t* KTG;
    __device__ __forceinline__ void plain(const f32x4 (&acc)[2][2][4][2], int bj, bf16_t* dst) const {
#pragma unroll
        for (int ai = 0; ai < 2; ++ai)
#pragma unroll
            for (int m = 0; m < 4; ++m) *(u32x4*)(dst + (size_t)(ai * HALF + m * 16) * PW) = pack8(acc[ai][bj][m][0], acc[ai][bj][m][1]);
    }
    __device__ __forceinline__ void head64(const f32x4 (&acc)[2][2][4][2], bf16_t* dst, const float* g, float sc, int jt, int wr, int fr, int fq, bf16_t* KT = nullptr) const {
        f32x4 gs[2][2];
#pragma unroll
        for (int bj = 0; bj < 2; ++bj)
#pragma unroll
            for (int n = 0; n < 2; ++n) gs[bj][n] = *(const f32x4*)(g + 32 * bj + 8 * fq + 4 * n) * sc;
        f32x4 cA[2][2];
        if (jt != 0) {
#pragma unroll
            for (int ai = 0; ai < 2; ++ai) { const f32x4* t = (const f32x4*)(ropeA + ((jt - 1) * 4 + ai * 2 + wr) * 16 + 4 * fq); cA[ai][0] = t[0]; cA[ai][1] = t[1]; } }
#pragma unroll
        for (int m = 0; m < 4; ++m) { f32x4 cB0, cB1;
            if (jt != 0) { const f32x4* t = (const f32x4*)(ropeA + (m * 16 + fr) * 16 + 4 * fq); cB0 = t[0]; cB1 = t[1]; }
#pragma unroll
            for (int ai = 0; ai < 2; ++ai) { f32x4 a0 = acc[ai][0][m][0], a1 = acc[ai][0][m][1], b0 = acc[ai][1][m][0], b1 = acc[ai][1][m][1];
                const float ss = quad_sum((dot4(a0) + dot4(a1)) + (dot4(b0) + dot4(b1)));
                const float rstd = __builtin_amdgcn_rsqf(ss * (1.f / 64.f) + NEPS);
                a0 = a0 * rstd * gs[0][0]; a1 = a1 * rstd * gs[0][1]; b0 = b0 * rstd * gs[1][0]; b1 = b1 * rstd * gs[1][1];
                if (jt != 0) { rot8(a0, a1, cA[ai][0], cA[ai][1]); rot8(b0, b1, cB0, cB1); }
                if (KT != nullptr) { bf16_t* o = KT + (size_t)(ai * 2) * 4096 + fq * 512 + (m * 16) * 8; *(u32x4*)o = pack8(a0, a1); *(u32x4*)(o + 4 * 512) = pack8(b0, b1); }
                else { bf16_t* o = dst + (size_t)(ai * HALF + m * 16) * PW; *(u32x4*)o = pack8(a0, a1); *(u32x4*)(o + HALF) = pack8(b0, b1); } } }
    }
    template <int MODE> __device__ __forceinline__ void blk32(const f32x4 (&acc)[2][2][4][2], int bj, bf16_t* dst, float sc, int tslot, int mslot, size_t row0, int jt, int wr, int wc, int fr, int fq) const {
        float rmax = 0.f;
#pragma unroll
        for (int ai = 0; ai < 2; ++ai)
#pragma unroll
            for (int m = 0; m < 4; ++m) { f32x4 a = acc[ai][bj][m][0], c = acc[ai][bj][m][1];
                if constexpr ((MODE & 6) != 0) { const float ss = quad_sum(dot4(a) + dot4(c));
                    if constexpr ((MODE & 2) != 0) rmax = fmaxf(rmax, ss);
                    if constexpr ((MODE & 4) != 0) { if (fq == 0) MS[(row0 + ai * HALF + m * 16) * 16 + mslot] = ss; } }
                if constexpr ((MODE & 1) != 0) { if (jt != 0) { const int pos = fq < 2 ? (jt - 1) * 4 + ai * 2 + wr : m * 16 + fr; const f32x4* t = (const f32x4*)(ropeB + pos * 8 + ((4 * fq) & 7)); rot8(a, c, t[0], t[1]); } }
                *(u32x4*)(dst + (size_t)(ai * HALF + m * 16) * PW) = pack8(a * sc, c * sc); }
        if constexpr ((MODE & 2) != 0) { rmax *= sc * sc;
            rmax = fmaxf(rmax, __builtin_bit_cast(float, __builtin_amdgcn_ds_swizzle(__builtin_bit_cast(int, rmax), (1 << 10) | 0x1f))); rmax = fmaxf(rmax, __builtin_bit_cast(float, __builtin_amdgcn_ds_swizzle(__builtin_bit_cast(int, rmax), (2 << 10) | 0x1f)));
            rmax = fmaxf(rmax, __builtin_bit_cast(float, __builtin_amdgcn_ds_swizzle(__builtin_bit_cast(int, rmax), (4 << 10) | 0x1f))); rmax = fmaxf(rmax, __builtin_bit_cast(float, __builtin_amdgcn_ds_swizzle(__builtin_bit_cast(int, rmax), (8 << 10) | 0x1f)));
            if (fr == 0 && fq == 0) { LAS float* p = bslot + (wr * 4 + wc) * 4 + tslot; *p = fmaxf(*p, rmax); } }
    }
    __device__ __forceinline__ void operator()(const f32x4 (&acc)[2][2][4][2], const Unit& u, int wr, int wc, int fr, int fq) const {
        const int jt = u.pm % TPB, pn = u.pn;
        const size_t row0 = (size_t)u.pm * BM + wr * 64 + fr;
        bf16_t* dst = P + row0 * PW + pn * BM + wc * 32 + 8 * fq;
        if (pn < 2) head64(acc, dst, gq, SC_G, jt, wr, fr, fq);
        else if (pn == 2) { if (wc < 2) head64(acc, dst, gk, 1.0f, jt, wr, fr, fq, KTG + ((size_t)wc * (MROWS / 64) + (size_t)u.pm * 4 + wr) * 4096 + fr * 8); else { plain(acc, 0, dst); plain(acc, 1, dst + HALF); } }
        else if (pn == 3) { blk32<3>(acc, 0, dst, SC_D, 0, 0, row0, jt, wr, wc, fr, fq); blk32<3>(acc, 1, dst + HALF, SC_D, 0, 0, row0, jt, wr, wc, fr, fq); }
        else if (pn == 4) { blk32<3>(acc, 0, dst, 1.0f, 1, 0, row0, jt, wr, wc, fr, fq); blk32<3>(acc, 1, dst + HALF, 1.0f, 1, 0, row0, jt, wr, wc, fr, fq); }
        else if (pn == 5) { plain(acc, 0, dst); plain(acc, 1, dst + HALF); }
        else if (pn == 6) { blk32<4>(acc, 0, dst, 1.0f, 0, wc, row0, jt, wr, wc, fr, fq); blk32<4>(acc, 1, dst + HALF, 1.0f, 0, wc < 2 ? 4 + wc : 6 + wc, row0, jt, wr, wc, fr, fq); }
        else { if (wc < 2) blk32<4>(acc, 0, dst, 1.0f, 0, 10 + wc, row0, jt, wr, wc, fr, fq); else if (wc == 2) blk32<3>(acc, 0, dst, 1.0f, 2, 0, row0, jt, wr, wc, fr, fq); else plain(acc, 0, dst); }
    }
};
}

#ifndef ATTN_STORE16
#define ATTN_STORE16(p,v) (*(u32x4*)(p)=(v))
#endif
namespace attn_body {
using bf16=__hip_bfloat16;
using bf16x8=__attribute__((ext_vector_type(8)))short;
using s16x4=__attribute__((ext_vector_type(4)))short;
using f32x16=__attribute__((ext_vector_type(16)))float;
using u32x4=__attribute__((ext_vector_type(4)))unsigned;
constexpr int D=64;
constexpr int NW=8,QBLK=32,QB=QBLK*NW,KVBLK=64;
__device__ __forceinline__ int crow(int r,int hi){return (r&3)+8*(r>>2)+4*hi;}
#define SBAR() __builtin_amdgcn_sched_barrier(0)
constexpr int NSLOT=3, SLOTB=8192;
constexpr int LDS_K=0, LDS_V=NSLOT*SLOTB, LDS_WS=2*NSLOT*SLOTB, LDS_OST=LDS_WS+NW*64*4, LDS_STASH=LDS_OST+NW*4096, LDS_BYTES=LDS_STASH+NW*4096;
constexpr float C2=0.125f*1.4426950408889634f;
__device__ __forceinline__ void glds16(const void*gsrc,unsigned lds_dst){unsigned keep;
  asm volatile("s_mov_b32 %0, m0\n\ts_mov_b32 m0, %2\n\ts_nop 0\n\tglobal_load_lds_dwordx4 %1, off\n\ts_mov_b32 m0, %0":"=&s"(keep):"v"(gsrc),"s"(lds_dst):"memory");}
__device__ __forceinline__ float max3f(float a,float b,float c){float r;asm("v_max3_f32 %0, %1, %2, %3":"=v"(r):"v"(a),"v"(b),"v"(c));return r;}
__device__ __forceinline__ float max2f(float a,float b){float r;asm("v_max_f32_e32 %0, %1, %2":"=v"(r):"v"(a),"v"(b));return r;}
__device__ __forceinline__ float fadd_s(float a,float b){float r;asm("v_add_f32_e32 %0, %1, %2":"=v"(r):"v"(a),"v"(b));return r;}
__device__ __forceinline__ float fsub_s(float a,float b){float r;asm("v_sub_f32_e32 %0, %1, %2":"=v"(r):"v"(a),"v"(b));return r;}
typedef float f32x2_t __attribute__((ext_vector_type(2))); typedef __bf16 bf16x2_t __attribute__((ext_vector_type(2)));
__device__ __forceinline__ unsigned cvtpk_s(float lo,float hi){f32x2_t v={lo,hi};bf16x2_t b=__builtin_convertvector(v,bf16x2_t);return __builtin_bit_cast(unsigned,b);}
#define WAIT_BAR(N) asm volatile("s_waitcnt vmcnt(" #N ") lgkmcnt(0)\n\ts_barrier":::"memory")

template<int NS_> __device__ __forceinline__ void qkt(f32x16&p0,f32x16&p1,const char*Kslot,const bf16x8*qr,const f32x16&negm,int r32,int hi){
  const char*kb=Kslot+hi*1024+r32*16;
  #pragma unroll
  for(int d0=0;d0<NS_;++d0){
    const bf16x8 b0=*reinterpret_cast<const bf16x8*>(kb+d0*2048);
    const bf16x8 b1=*reinterpret_cast<const bf16x8*>(kb+d0*2048+512);
    if(d0==0){p0=__builtin_amdgcn_mfma_f32_32x32x16_bf16(b0,qr[0],negm,0,0,0);p1=__builtin_amdgcn_mfma_f32_32x32x16_bf16(b1,qr[0],negm,0,0,0);}
    else{p0=__builtin_amdgcn_mfma_f32_32x32x16_bf16(b0,qr[d0],p0,0,0,0);p1=__builtin_amdgcn_mfma_f32_32x32x16_bf16(b1,qr[d0],p1,0,0,0);}}
}
typedef __attribute__((address_space(3))) const char* lds_cptr;
typedef short v4i16_t __attribute__((ext_vector_type(4)));
__device__ __forceinline__ void kload8(bf16x8*kf,lds_cptr kp){
  kf[0]=*(const __attribute__((address_space(3))) bf16x8*)(kp);      kf[1]=*(const __attribute__((address_space(3))) bf16x8*)(kp+512);
  kf[2]=*(const __attribute__((address_space(3))) bf16x8*)(kp+2048); kf[3]=*(const __attribute__((address_space(3))) bf16x8*)(kp+2560);
  kf[4]=*(const __attribute__((address_space(3))) bf16x8*)(kp+4096); kf[5]=*(const __attribute__((address_space(3))) bf16x8*)(kp+4608);
  kf[6]=*(const __attribute__((address_space(3))) bf16x8*)(kp+6144); kf[7]=*(const __attribute__((address_space(3))) bf16x8*)(kp+6656);
}
__device__ __forceinline__ void kload2(bf16x8*kf,lds_cptr kp,int j){ kf[2*j]=*(const __attribute__((address_space(3))) bf16x8*)(kp+j*2048); kf[2*j+1]=*(const __attribute__((address_space(3))) bf16x8*)(kp+j*2048+512); }
__device__ __forceinline__ s16x4 vtr(lds_cptr p){ return __builtin_bit_cast(s16x4,__builtin_amdgcn_ds_read_tr16_b64_v4i16((__attribute__((address_space(3))) v4i16_t*)p)); }
__device__ __forceinline__ float rowmax(const f32x16&p0,const f32x16&p1){
  float a=max3f(p0[0],p0[1],p1[0]),b=max3f(p0[2],p0[3],p1[1]);a=max3f(a,p1[2],p1[3]);
  #pragma unroll
  for(int r=4;r<16;r+=4){a=max3f(a,p0[r],p0[r+1]);b=max3f(b,p0[r+2],p0[r+3]);a=max3f(a,p1[r],p1[r+1]);b=max3f(b,p1[r+2],p1[r+3]);}
  const float m=max2f(a,b);
  auto rr=__builtin_amdgcn_permlane32_swap(__float_as_uint(m),__float_as_uint(m),false,false);
  return max2f(__uint_as_float(rr[0]),__uint_as_float(rr[1]));
}
__device__ __forceinline__ void pv(f32x16*o,int vb,bf16x8 pa0,bf16x8 pa1,bf16x8 pa2,bf16x8 pa3){
  #pragma unroll
  for(int d0=0;d0<2;++d0){s16x4 lo[4],hi[4];
    #pragma unroll
    for(int ks=0;ks<4;++ks){
      asm volatile("ds_read_b64_tr_b16 %0,%1 offset:%c2":"=&v"(lo[ks]):"v"(vb),"i"(d0*4096+ks*1024):"memory");
      asm volatile("ds_read_b64_tr_b16 %0,%1 offset:%c2":"=&v"(hi[ks]):"v"(vb),"i"(d0*4096+ks*1024+512):"memory");}
    asm volatile("s_waitcnt lgkmcnt(0)":::"memory");SBAR();
    #define PK(k) (bf16x8){lo[k][0],lo[k][1],lo[k][2],lo[k][3],hi[k][0],hi[k][1],hi[k][2],hi[k][3]}
    o[d0]=__builtin_amdgcn_mfma_f32_32x32x16_bf16(pa0,PK(0),o[d0],0,0,0);
    o[d0]=__builtin_amdgcn_mfma_f32_32x32x16_bf16(pa1,PK(1),o[d0],0,0,0);
    o[d0]=__builtin_amdgcn_mfma_f32_32x32x16_bf16(pa2,PK(2),o[d0],0,0,0);
    o[d0]=__builtin_amdgcn_mfma_f32_32x32x16_bf16(pa3,PK(3),o[d0],0,0,0);
    #undef PK
  }
}

#ifndef ATTN_STORE16
#define ATTN_STORE16(p,v) (*(u32x4*)(p)=(v))
#endif
template<int THRL,int QM,int EPI,int DK=64,bool NOMAX=false,int HS=32,bool KTL=false> __device__ __forceinline__ void attn_unit(const bf16*Qw0,int qp,const bf16*__restrict__ Kh,int kp,const bf16*__restrict__ Vh,int vp,bf16*Ow0,int op,const int NT,char*shm,float lam,float oml,const float*gsub,const bf16*__restrict__ Kh2=nullptr,int kp2=0,const f32x2_t*rope=nullptr,int qpos0=-1){
  constexpr int qmask=QM, epi=EPI; constexpr int NS=DK/16, NKP=DK/8, SLOTK=NKP*1024;
  constexpr int L_K=0, L_V=NSLOT*SLOTK, L_WS=L_V+NSLOT*SLOTB, L_OST=L_WS+NW*64*4, L_STASH=L_OST+NW*4096;
  #define KOFF(sl) (((sl)>>13)*SLOTK)
  int tid_=threadIdx.x; asm volatile("":"+v"(tid_)); const int tid=tid_,lane=tid&63,r32=lane&31,hi=lane>>5; const int wid=__builtin_amdgcn_readfirstlane(tid>>6);
  const bf16*Qw=Qw0+(long)(wid*QBLK)*qp;
  const unsigned lds0=(unsigned)(uintptr_t)shm;
  float*wsf=(float*)(shm+L_WS)+wid*64;
  const bf16*ksrc=KTL?(Kh+wid*512+lane*8):(Kh+(long)lane*kp+(wid&3)*8+(wid>>2)*HS);
  const bf16*ksrc2=Kh2+(long)lane*kp2+wid*8; const long kstep2=(long)KVBLK*kp2;
  const bf16*vsrc=Vh+(long)(16*(wid&3)+(lane>>2))*vp+(wid>>2)*HS+(lane&3)*8;
  const long kstep=KTL?4096L:(long)KVBLK*kp, vstep=(long)KVBLK*vp;
  const unsigned kdst=lds0+L_K+wid*1024, vdst=lds0+L_V+wid*1024;
  #define DMA_K(t,slot) do{ glds16(ksrc+(long)(t)*kstep,(unsigned)__builtin_amdgcn_readfirstlane(kdst+KOFF(slot))); \
      if constexpr(NKP>8){ if(wid<NKP-8) glds16(ksrc2+(long)(t)*kstep2,(unsigned)__builtin_amdgcn_readfirstlane(kdst+KOFF(slot)+8192)); } }while(0)
  #define WAITB2() do{ if constexpr(NKP>8){ if(wid<NKP-8){WAIT_BAR(3);} else {WAIT_BAR(2);} } else {WAIT_BAR(2);} }while(0)
  #define DMA_V(t,slot) glds16(vsrc+(long)(t)*vstep,(unsigned)__builtin_amdgcn_readfirstlane(vdst+(slot)))
  const int vb0=(int)(lds0+L_V)+((lane>>4)&1)*32+(lane&3)*8+(4*hi+((lane&15)>>2))*64;
  const char*Kbase=shm+L_K; bf16x8 kf[NKP];
  const lds_cptr shm3=(lds_cptr)shm; const lds_cptr kp0=shm3+L_K+hi*1024+r32*16; const lds_cptr vp0=shm3+L_V+((lane>>4)&1)*32+(lane&3)*8+(4*hi+((lane&15)>>2))*64;
  DMA_K(0,0);DMA_V(0,0);DMA_K(1,SLOTB);
  bf16x8 qr[NS];
  #pragma unroll
  for(int d0=0;d0<NS;++d0)qr[d0]=*reinterpret_cast<const bf16x8*>(&Qw[(long)r32*qp+(d0>>1)*HS+(d0&1)*16+hi*8]);
  if constexpr(DK==96){
    if(qpos0==-2){qr[4]=bf16x8{};qr[5]=bf16x8{};}
    else if(qpos0>=0){ const int s_=qpos0+wid*QBLK+r32;
      _Pragma("unroll") for(int k=0;k<2;++k){ const int i0=8*k+4*hi; const f32x2_t*cs=rope+(i0<8?(s_>>6):(s_&63))*8+(i0&7);
        const u32x4 w=__builtin_bit_cast(u32x4,qr[4+k]); const unsigned ww[4]={w.x,w.y,w.z,w.w}; unsigned oo[4];
        _Pragma("unroll") for(int j=0;j<4;++j){ const f32x2_t c=cs[j]; const float x1=__uint_as_float(ww[j]<<16),x2=__uint_as_float(ww[j]&0xffff0000u); oo[j]=cvtpk_s(x1*c.x-x2*c.y,x1*c.y+x2*c.x); }
        const u32x4 o_={oo[0],oo[1],oo[2],oo[3]}; qr[4+k]=__builtin_bit_cast(bf16x8,o_); } } }
  if(qmask==1){qr[2]=bf16x8{};qr[3]=bf16x8{};} if(qmask==2){qr[0]=bf16x8{};qr[1]=bf16x8{};}
  float mhat=0.f,l_reg=0.f;f32x16 o[2];o[0]=f32x16{};o[1]=f32x16{};f32x16 negm=f32x16{}; if constexpr(!NOMAX) asm volatile("":"+v"(negm));
  #define CMASK(P0,P1,t) do{}while(0)
  bool resc=false;
  #define START(P0,P1) do{ resc=false; if constexpr(!NOMAX) { const float rm=rowmax(P0,P1); \
    { const float dl=rm; mhat=fadd_s(mhat,dl); \
      _Pragma("unroll") for(int r=0;r<16;++r){P0[r]=fsub_s(P0[r],dl);P1[r]=fsub_s(P1[r],dl);} \
      _Pragma("unroll") for(int r=0;r<16;++r)negm[r]=-mhat; asm volatile("":"+v"(negm)); } } \
    _Pragma("unroll") for(int r=0;r<16;++r)P0[r]=__builtin_amdgcn_exp2f(P0[r]); }while(0)
  #define RESC() do{ if(resc){ asm volatile("s_waitcnt lgkmcnt(0)":::"memory"); \
      _Pragma("unroll") for(int d_=0;d_<2;++d_) _Pragma("unroll") for(int r=0;r<16;++r)o[d_][r]*=wsf[crow(r,hi)]; } }while(0)
  f32x16 pA0,pA1,pB0,pB1;
  int sl_prev=0,sl_cur=0,sl_next=SLOTB;
  #define ROT() do{sl_prev=sl_cur;sl_cur=sl_next;sl_next=(sl_next==(NSLOT-1)*SLOTB)?0:sl_next+SLOTB;}while(0)
  DMA_K(2,2*SLOTB);
  if constexpr(NKP>8){ if(wid<NKP-8){WAIT_BAR(5);} else {WAIT_BAR(3);} } else {WAIT_BAR(3);}
  qkt<NS>(pA0,pA1,Kbase,qr,negm,r32,hi);asm volatile("s_nop 15\n\ts_nop 7":"+v"(pA0),"+v"(pA1));CMASK(pA0,pA1,0);
  START(pA0,pA1);
  _Pragma("unroll") for(int r=0;r<16;++r)pA1[r]=__builtin_amdgcn_exp2f(pA1[r]);
  WAIT_BAR(0);
  DMA_K(3,0);DMA_V(1,SLOTB);
  ROT();
  _Pragma("unroll") for(int j=0;j<NS;++j){ if constexpr(QM==1){ if(j>=2&&j<4)continue; } if constexpr(QM==2){ if(j<2)continue; } kload2(kf,kp0+KOFF(sl_cur),j); }
  WAITB2();
  s16x4 vlo[8],vhi[8]; u32x4 pw0,pw1,pw2,pw3;
  #define PKW(P,B) cvtpk_s(P[B],P[B+1])
  #define PAF(k) __builtin_bit_cast(bf16x8,pw##k)
  #define VFR(i) (bf16x8){vlo[i][0],vlo[i][1],vlo[i][2],vlo[i][3],vhi[i][0],vhi[i][1],vhi[i][2],vhi[i][3]}
  #define PIN(x) asm volatile("":"+v"(x))
  #define MX3(a,b,c) __builtin_fmaxf(__builtin_fmaxf((a),(b)),(c))
  #define GAPA(MF,A0,A1,A2,A3,W0,W1,PW) do{ MF; sacc+=A0; sacc2+=A1; sacc+=A2; sacc2+=A3; PIN(sacc); PIN(sacc2); W0; W1; PIN(PW); SBAR(); }while(0)
  #define EX(v) __builtin_amdgcn_exp2f(v)
  #define GAPB(MF,X,B) do{ MF; X[B]=EX(X[B]); X[B+1]=EX(X[B+1]); X[B+2]=EX(X[B+2]); X[B+3]=EX(X[B+3]); PIN(X); SBAR(); }while(0)
  #define VRD(i) do{ vlo[i]=vtr(vp_+(((i)>>2)*4096+((i)&3)*1024)); vhi[i]=vtr(vp_+(((i)>>2)*4096+((i)&3)*1024+512)); }while(0)
  #define KRD(G,j) do{ if constexpr(!((QM==1&&(j)>=2&&(j)<4)||(QM==2&&(j)<2))){ if(G){ kload2(kf,kp0+KOFF(sl_next),j); SBAR(); } } }while(0)
  #define MFLO(C,ki,qi,init) do{ if constexpr(QM!=2){ C=__builtin_amdgcn_mfma_f32_32x32x16_bf16(kf[ki],qr[qi],init,0,0,0); } }while(0)
  #define MFHI0(C,ki,qi) do{ if constexpr(QM==2){ C=__builtin_amdgcn_mfma_f32_32x32x16_bf16(kf[ki],qr[qi],negm,0,0,0); } else if constexpr(QM==0){ C=__builtin_amdgcn_mfma_f32_32x32x16_bf16(kf[ki],qr[qi],C,0,0,0); } }while(0)
  #define MFHI1(C,ki,qi) do{ if constexpr(QM!=1){ C=__builtin_amdgcn_mfma_f32_32x32x16_bf16(kf[ki],qr[qi],C,0,0,0); } }while(0)
  #define STEP(C0,C1,P0,P1,t,GK,GV,GL) do{ SBAR(); \
    const lds_cptr vp_=vp0+sl_prev; \
    VRD(0); SBAR(); float sacc=P0[0], sacc2=P0[1]; \
    GAPA(MFLO(C0,0,0,negm), P0[2],P0[3],P0[4],P0[5],     pw0[0]=PKW(P0,0), pw0[1]=PKW(P0,2), pw0); \
    VRD(4); SBAR(); GAPA(MFLO(C1,1,0,negm), P0[6],P0[7],P0[8],P0[9],     pw0[2]=PKW(P0,4), pw0[3]=PKW(P0,6), pw0); \
    VRD(1); SBAR(); GAPA(MFLO(C0,2,1,C0),   P0[10],P0[11],P0[12],P0[13], pw1[0]=PKW(P0,8), pw1[1]=PKW(P0,10), pw1); \
    VRD(5); SBAR(); GAPA(MFLO(C1,3,1,C1),   P0[14],P0[15],P1[0],P1[1],   pw1[2]=PKW(P0,12),pw1[3]=PKW(P0,14), pw1); \
    VRD(2); SBAR(); GAPA(MFHI0(C0,4,2),   P1[2],P1[3],P1[4],P1[5],     pw2[0]=PKW(P1,0), pw2[1]=PKW(P1,2), pw2); \
    VRD(6); SBAR(); GAPA(MFHI0(C1,5,2),   P1[6],P1[7],P1[8],P1[9],     pw2[2]=PKW(P1,4), pw2[3]=PKW(P1,6), pw2); \
    VRD(3); SBAR(); GAPA(MFHI1(C0,6,3),   P1[10],P1[11],P1[12],P1[13], pw3[0]=PKW(P1,8), pw3[1]=PKW(P1,10), pw3); \
    VRD(7); SBAR(); GAPA(MFHI1(C1,7,3),   P1[14],P1[15],0.f,0.f,       pw3[2]=PKW(P1,12),pw3[3]=PKW(P1,14), pw3); \
    if constexpr(DK==96){ C0=__builtin_amdgcn_mfma_f32_32x32x16_bf16(kf[8],qr[4],C0,0,0,0); C1=__builtin_amdgcn_mfma_f32_32x32x16_bf16(kf[9],qr[4],C1,0,0,0); \
                          C0=__builtin_amdgcn_mfma_f32_32x32x16_bf16(kf[10],qr[5],C0,0,0,0); C1=__builtin_amdgcn_mfma_f32_32x32x16_bf16(kf[11],qr[5],C1,0,0,0); SBAR(); } \
    l_reg+=(sacc+sacc2); \
    if(GK){DMA_K((t)+3,sl_cur);} if(GV){DMA_V((t)+1,sl_next);} \
    CMASK(C0,C1,t); \
    if constexpr(NOMAX){ resc=false; } else { float a=MX3(C0[0],C0[1],C1[0]),b=MX3(C0[2],C0[3],C1[1]); a=MX3(a,C1[2],C1[3]); \
      _Pragma("unroll") for(int r=4;r<16;r+=4){a=MX3(a,C0[r],C0[r+1]);b=MX3(b,C0[r+2],C0[r+3]);a=MX3(a,C1[r],C1[r+1]);b=MX3(b,C1[r+2],C1[r+3]);} \
      float rm=__builtin_fmaxf(a,b); { auto rr=__builtin_amdgcn_permlane32_swap(__float_as_uint(rm),__float_as_uint(rm),false,false); rm=__builtin_fmaxf(__uint_as_float(rr[0]),__uint_as_float(rr[1])); } \
      resc=false; \
      if(__builtin_expect(__any(rm>(float)THRL),0)){ const float dl=__builtin_fmaxf(rm,0.f); mhat+=dl; \
        _Pragma("unroll") for(int r=0;r<16;++r){C0[r]-=dl;C1[r]-=dl;} \
        _Pragma("unroll") for(int r=0;r<16;++r)negm[r]=-mhat; asm volatile("":"+v"(negm)); \
        const float f=__builtin_amdgcn_exp2f(-dl); l_reg*=f; if(hi==0)wsf[r32]=f; resc=true; } } \
    SBAR(); \
    GAPB(o[0]=__builtin_amdgcn_mfma_f32_32x32x16_bf16(PAF(0),VFR(0),o[0],0,0,0), C0,0); \
    GAPB(o[1]=__builtin_amdgcn_mfma_f32_32x32x16_bf16(PAF(0),VFR(4),o[1],0,0,0), C0,4); \
    KRD(GL,0); GAPB(o[0]=__builtin_amdgcn_mfma_f32_32x32x16_bf16(PAF(1),VFR(1),o[0],0,0,0), C0,8); \
    KRD(GL,1); GAPB(o[1]=__builtin_amdgcn_mfma_f32_32x32x16_bf16(PAF(1),VFR(5),o[1],0,0,0), C0,12); \
    KRD(GL,2); GAPB(o[0]=__builtin_amdgcn_mfma_f32_32x32x16_bf16(PAF(2),VFR(2),o[0],0,0,0), C1,0); \
    KRD(GL,3); GAPB(o[1]=__builtin_amdgcn_mfma_f32_32x32x16_bf16(PAF(2),VFR(6),o[1],0,0,0), C1,4); \
    if constexpr(DK==96){ KRD(GL,4); } GAPB(o[0]=__builtin_amdgcn_mfma_f32_32x32x16_bf16(PAF(3),VFR(3),o[0],0,0,0), C1,8); \
    if constexpr(DK==96){ KRD(GL,5); } GAPB(o[1]=__builtin_amdgcn_mfma_f32_32x32x16_bf16(PAF(3),VFR(7),o[1],0,0,0), C1,12); \
    }while(0)
  if(wid>=4)__builtin_amdgcn_s_setprio(1);
  int t=1;
  for(;t+5<NT;t+=2){
    STEP(pB0,pB1,pA0,pA1,t,true,true,true);     WAITB2(); RESC(); ROT();
    STEP(pA0,pA1,pB0,pB1,t+1,true,true,true);   WAITB2(); RESC(); ROT();
  }
  #define ENDW(tt) do{ if((tt)+3<NT){WAITB2();} else if((tt)+2<NT){WAIT_BAR(1);} else {WAIT_BAR(0);} }while(0)
  for(;t+1<NT;t+=2){
    STEP(pB0,pB1,pA0,pA1,t,(t+3<NT),(t+1<NT),(t+1<NT));       ENDW(t);   RESC(); ROT();
    STEP(pA0,pA1,pB0,pB1,t+1,(t+4<NT),(t+2<NT),(t+2<NT));     ENDW(t+1); RESC(); ROT();
  }
  STEP(pB0,pB1,pA0,pA1,NT-1,false,false,false); RESC();
  { float sacc=pB0[0]+pB0[1]; _Pragma("unroll") for(int r=2;r<16;++r)sacc+=pB0[r]; _Pragma("unroll") for(int r=0;r<16;++r)sacc+=pB1[r]; l_reg+=sacc;
    pw0=(u32x4){PKW(pB0,0),PKW(pB0,2),PKW(pB0,4),PKW(pB0,6)};pw1=(u32x4){PKW(pB0,8),PKW(pB0,10),PKW(pB0,12),PKW(pB0,14)};pw2=(u32x4){PKW(pB1,0),PKW(pB1,2),PKW(pB1,4),PKW(pB1,6)};pw3=(u32x4){PKW(pB1,8),PKW(pB1,10),PKW(pB1,12),PKW(pB1,14)};
    SBAR(); pv(o,vb0+sl_cur,PAF(0),PAF(1),PAF(2),PAF(3)); }
  #undef PKW
  #undef PAF
  #undef VFR
  #undef PIN
  #undef MX3
  #undef GAPA
  #undef GAPB
  #undef EX
  #undef VRD
  #undef KRD
  #undef STEP
  #undef MFLO
  #undef MFHI0
  #undef MFHI1
  #undef ENDW
  #undef KOFF
  #undef WAITB2
  __builtin_amdgcn_s_setprio(0);
  {auto rr=__builtin_amdgcn_permlane32_swap(__float_as_uint(l_reg),__float_as_uint(l_reg),false,false);l_reg=__uint_as_float(rr[0])+__uint_as_float(rr[1]);}
  if(hi==0)wsf[32+r32]=l_reg;asm volatile("s_waitcnt lgkmcnt(0)":::"memory");
  float rli[16];
  #pragma unroll
  for(int r=0;r<16;++r)rli[r]=__builtin_amdgcn_rcpf(wsf[32+crow(r,hi)]);
  bf16*Ow=Ow0+(long)(wid*QBLK)*op;
  { bf16*stg=(bf16*)(shm+(epi==1?L_STASH:L_OST))+wid*2048;
    #pragma unroll
    for(int r=0;r<16;++r){const int orow=crow(r,hi);
      #pragma unroll
      for(int d0=0;d0<2;++d0)stg[orow*64+d0*32+r32]=__float2bfloat16(o[d0][r]*rli[r]);}
    asm volatile("s_waitcnt lgkmcnt(0)":::"memory");
    if(epi==0){
      #pragma unroll
      for(int i=0;i<4;++i){const int row=i*8+(lane>>3),ch=lane&7; const u32x4 v=*(const u32x4*)(stg+row*64+ch*8); ATTN_STORE16(Ow+(long)row*op+ch*8,v);}
    } else if(epi==2){
      const bf16*sth=(const bf16*)(shm+L_STASH)+wid*2048; const int ch=lane&7; float gs[8];
      #pragma unroll
      for(int k=0;k<8;++k)gs[k]=gsub[ch*8+k]*oml;
      #pragma unroll
      for(int i=0;i<4;++i){const int row=i*8+(lane>>3); const u32x4 v1=*(const u32x4*)(stg+row*64+ch*8), v0=*(const u32x4*)(sth+row*64+ch*8);
        float a[8]; const unsigned w0[4]={v0.x,v0.y,v0.z,v0.w}, w1[4]={v1.x,v1.y,v1.z,v1.w}; float ss=0.f;
        #pragma unroll
        for(int k=0;k<4;++k){ a[2*k]=__uint_as_float(w0[k]<<16)-lam*__uint_as_float(w1[k]<<16); a[2*k+1]=__uint_as_float(w0[k]&0xffff0000u)-lam*__uint_as_float(w1[k]&0xffff0000u); ss+=a[2*k]*a[2*k]+a[2*k+1]*a[2*k+1]; }
        ss+=__builtin_bit_cast(float,__builtin_amdgcn_ds_swizzle(__builtin_bit_cast(int,ss),(1<<10)|0x1f)); ss+=__builtin_bit_cast(float,__builtin_amdgcn_ds_swizzle(__builtin_bit_cast(int,ss),(2<<10)|0x1f)); ss+=__builtin_bit_cast(float,__builtin_amdgcn_ds_swizzle(__builtin_bit_cast(int,ss),(4<<10)|0x1f));
        const float rstd=1.0f/sqrtf(ss*(1.f/64.f)+1e-6f);
        u32x4 ov; ov.x=cvtpk_s(a[0]*rstd*gs[0],a[1]*rstd*gs[1]); ov.y=cvtpk_s(a[2]*rstd*gs[2],a[3]*rstd*gs[3]); ov.z=cvtpk_s(a[4]*rstd*gs[4],a[5]*rstd*gs[5]); ov.w=cvtpk_s(a[6]*rstd*gs[6],a[7]*rstd*gs[7]);
        ATTN_STORE16(Ow+(long)row*op+ch*8,ov);}
    } }
  asm volatile("s_waitcnt lgkmcnt(0)\n\ts_barrier":::"memory");
  #undef DMA_K
  #undef DMA_V
  #undef CMASK
  #undef START
  #undef RESC
  #undef ROT
}
constexpr int ATTN_LDS_BYTES=LDS_BYTES;
#undef SBAR
#undef WAIT_BAR
}

constexpr size_t MiB = 1u << 20;
constexpr size_t WS_CTL = 0, CTL_ZERO_BYTES = 1 * MiB;
constexpr size_t WS_MODV = 1 * MiB;
constexpr size_t WS_ROPEA = 1 * MiB + 448 * 1024;
constexpr size_t WS_ROPEB = 1 * MiB + 456 * 1024;
constexpr size_t WS_LAM = 1 * MiB + 460 * 1024;
constexpr size_t WS_BND = 1 * MiB + 464 * 1024;
constexpr size_t WS_WIN = 2 * MiB;
constexpr size_t WS_WOUT = 10 * MiB;
constexpr size_t WS_WU = 14 * MiB;
constexpr size_t WS_WUKV = 15 * MiB;
constexpr size_t WS_FIN = 16 * MiB;
constexpr size_t WS_FOUT = 27 * MiB;
constexpr size_t WS_X = 34 * MiB;
constexpr size_t WS_QM = 170 * MiB;
constexpr size_t WS_KN = 196 * MiB;
constexpr size_t WS_VM = 213 * MiB;
constexpr size_t WS_MIN = 170 * MiB;
constexpr size_t WS_MOUT = 226 * MiB;
constexpr size_t WS_H = 254 * MiB;
constexpr size_t WS_P = 322 * MiB;
constexpr size_t WS_ACT = 322 * MiB;
constexpr size_t WS_ACTC = 254 * MiB;
constexpr size_t WS_FIN8 = 102 * MiB;
constexpr size_t WS_FOUT8 = 108 * MiB;
constexpr size_t WS_H8 = 111 * MiB;
constexpr size_t WS_ACT8 = 113 * MiB;
constexpr size_t WS_MS = 120 * MiB;
constexpr size_t WS_KTG = 124 * MiB;
constexpr size_t WS_AMOE8 = 102 * MiB;
constexpr size_t WS_TOKE = 378 * MiB;
constexpr size_t WS_TOKW = 378 * MiB + 256 * 1024;
constexpr size_t WS_TOKS = 378 * MiB + 512 * 1024;
constexpr size_t WS_TILEE = 378 * MiB + 768 * 1024;
constexpr size_t WS_AMOE = 380 * MiB;
constexpr size_t WS_END = 512 * MiB;
constexpr int CW_BAR = 4096, CW_CNT = 8192, CW_FILL = 8192 + 512, CW_HO = 12288;
constexpr int RING_BYTES = 131072, LDSCTL_OFF = RING_BYTES, MISC_OFF = LDSCTL_OFF + 320, LDS_BYTES = 147456;
constexpr int NWAVES = 8;

#define XB_TMO      128
#define XB_XCNT(j)  (256  + 64 * (j))
#define XB_XSUB(j)  (1280 + 64 * (j))
#define XB_XGEN(j)  (2304 + 64 * (j))
#define XB_TOP      3328
#define XB_TOPGEN   3392
#define XCD_BAR_WORDS 3456
#define XB_SPIN_CAP (1u << 18)
__device__ __forceinline__ unsigned xb_ld(unsigned* p)              { return __hip_atomic_load(p, __ATOMIC_RELAXED, __HIP_MEMORY_SCOPE_AGENT); }
__device__ __forceinline__ unsigned xb_add(unsigned* p, unsigned v) { return __hip_atomic_fetch_add(p, v, __ATOMIC_RELAXED, __HIP_MEMORY_SCOPE_AGENT); }
__device__ __forceinline__ unsigned xb_xcc_id() { return (unsigned)__builtin_amdgcn_s_getreg((3 << 11) | 20) & 0xFu; }
#define XB_SPIN(cond, bar) do { unsigned _sp = 0; while (cond) { __builtin_amdgcn_s_sleep(1); \
    if ((++_sp & 255u) == 0u) { if (xb_ld(&(bar)[XB_TMO])) break; if (_sp > XB_SPIN_CAP) { atomicAdd(&(bar)[XB_TMO], 1u); break; } } } } while (0)
struct XcdBarrier { unsigned* bar; unsigned x; volatile LAS unsigned* st; };
__device__ __forceinline__ XcdBarrier xcd_barrier_post(unsigned* bar, volatile LAS unsigned* st) {
    XcdBarrier b; b.bar = bar; b.x = xb_xcc_id(); b.st = st;
    if (threadIdx.x == 0) (void)xb_add(&bar[XB_XCNT(b.x)], 1u);
    return b;
}
__device__ __forceinline__ void xcd_barrier_complete(unsigned* bar, unsigned x, unsigned& nloc, unsigned& nx) {
    const unsigned G = gridDim.x * gridDim.y * gridDim.z;
    unsigned sum, cnt, mine, sp = 0u;
    for (;;) {
        sum = 0u; cnt = 0u; mine = 0u;
#pragma unroll
        for (unsigned j = 0; j < 16; ++j) { const unsigned c = xb_ld(&bar[XB_XCNT(j)]); sum += c; cnt += (c > 0u) ? 1u : 0u; mine = (j == x) ? c : mine; }
        if (sum == G) break;
        __builtin_amdgcn_s_sleep(1);
        if ((++sp & 255u) == 0u) { if (xb_ld(&bar[XB_TMO])) break; if (sp > XB_SPIN_CAP) { atomicAdd(&bar[XB_TMO], 1u); break; } }
    }
    nloc = mine > 0u ? mine : 1u; nx = cnt > 0u ? cnt : 1u;
}
__device__ __forceinline__ void xcd_barrier(const XcdBarrier& b) {
    asm volatile("s_waitcnt vmcnt(0)" ::: "memory");
    __syncthreads();
    if (threadIdx.x == 0) {
        unsigned* bar = b.bar;
        __builtin_amdgcn_s_waitcnt(0);
        unsigned nloc = b.st[0], nx = b.st[1];
        if (nloc == 0u) { xcd_barrier_complete(bar, b.x, nloc, nx); b.st[0] = nloc; b.st[1] = nx; }
        const unsigned old = xb_add(&bar[XB_XSUB(b.x)], 1u);
        const unsigned gen = old / nloc;
        if (old + 1u == (gen + 1u) * nloc) {
            __builtin_amdgcn_fence(__ATOMIC_RELEASE, "agent");
            asm volatile("s_waitcnt vmcnt(0)" ::: "memory");
            const unsigned og = xb_add(&bar[XB_TOP], 1u);
            const unsigned tg = og / nx;
            if (og + 1u == (tg + 1u) * nx) xb_add(&bar[XB_TOPGEN], 1u);
            else XB_SPIN(xb_ld(&bar[XB_TOPGEN]) == tg, bar);
            __builtin_amdgcn_fence(__ATOMIC_ACQUIRE, "agent");
            xb_add(&bar[XB_XGEN(b.x)], 1u);
            asm volatile("s_waitcnt vmcnt(0)" ::: "memory");
        } else {
            XB_SPIN(xb_ld(&bar[XB_XGEN(b.x)]) == gen, bar);
            __builtin_amdgcn_fence(__ATOMIC_ACQUIRE, "agent");
            asm volatile("s_waitcnt vmcnt(0)" ::: "memory");
        }
    }
    __syncthreads();
}

__device__ __forceinline__ void ctx_handoff(unsigned* ctl, int slot) {
    asm volatile("s_waitcnt vmcnt(0)" ::: "memory");
    __syncthreads();
    if (threadIdx.x == 0) {
        unsigned* bar = ctl + CW_BAR; unsigned* w = ctl + CW_HO + 64 * slot;
        __builtin_amdgcn_fence(__ATOMIC_RELEASE, "agent");
        asm volatile("s_waitcnt vmcnt(0)" ::: "memory");
        (void)xb_add(w, 1u);
        XB_SPIN(xb_ld(w) < 4u, bar);
        __builtin_amdgcn_fence(__ATOMIC_ACQUIRE, "agent");
        asm volatile("s_waitcnt vmcnt(0)" ::: "memory");
    }
    __syncthreads();
}

#define SWZ_XOR(v, X) __builtin_bit_cast(float, __builtin_amdgcn_ds_swizzle(__builtin_bit_cast(int, (v)), ((X) << 10) | 0x1f))
__device__ __forceinline__ float group8_sum(float v) { v += SWZ_XOR(v, 1); v += SWZ_XOR(v, 2); v += SWZ_XOR(v, 4); return v; }
__device__ __forceinline__ float wave_sum(float v) {
    v += SWZ_XOR(v, 1); v += SWZ_XOR(v, 2); v += SWZ_XOR(v, 4); v += SWZ_XOR(v, 8); v += SWZ_XOR(v, 16);
    auto rr = __builtin_amdgcn_permlane32_swap(__float_as_uint(v), __float_as_uint(v), false, false);
    return __uint_as_float(rr[0]) + __uint_as_float(rr[1]);
}
__device__ __forceinline__ float wave_max(float v) {
    v = fmaxf(v, SWZ_XOR(v, 1)); v = fmaxf(v, SWZ_XOR(v, 2)); v = fmaxf(v, SWZ_XOR(v, 4)); v = fmaxf(v, SWZ_XOR(v, 8)); v = fmaxf(v, SWZ_XOR(v, 16));
    auto rr = __builtin_amdgcn_permlane32_swap(__float_as_uint(v), __float_as_uint(v), false, false);
    return fmaxf(__uint_as_float(rr[0]), __uint_as_float(rr[1]));
}
__device__ __forceinline__ void unpack8(const u32x4 w, float (&v)[8]) { v[0] = bflo(w.x); v[1] = bfhi(w.x); v[2] = bflo(w.y); v[3] = bfhi(w.y); v[4] = bflo(w.z); v[5] = bfhi(w.z); v[6] = bflo(w.w); v[7] = bfhi(w.w); }
__device__ __forceinline__ u32x4 pack8f(const float (&v)[8]) { u32x4 w; w.x = cvtpk(v[0], v[1]); w.y = cvtpk(v[2], v[3]); w.z = cvtpk(v[4], v[5]); w.w = cvtpk(v[6], v[7]); return w; }
__device__ __forceinline__ void rope4(float (&v)[8], const f32x2* cs) {
#pragma unroll
    for (int k = 0; k < 4; ++k) { const f32x2 c = cs[k]; const float x1 = v[2 * k], x2 = v[2 * k + 1]; v[2 * k] = x1 * c.x - x2 * c.y; v[2 * k + 1] = x1 * c.y + x2 * c.x; }
}
__device__ __forceinline__ void sincos_small(float a, float& sn, float& cs) {
    const float n = rintf(a * 0.6366197723675814f);
    float r = fmaf(-n, 1.5703125f, a); r = fmaf(-n, 4.837512969970703125e-4f, r); r = fmaf(-n, 7.54978995489188216e-8f, r);
    const float z = r * r;
    const float s = r + r * z * ((-1.9515295891e-4f * z + 8.3321608736e-3f) * z - 1.6666654611e-1f);
    const float c = 1.0f - 0.5f * z + z * z * ((2.443315711809948e-5f * z - 1.388731625493765e-3f) * z + 4.166664568298827e-2f);
    const int q = ((int)n) & 3;
    sn = (q == 0) ? s : (q == 1) ? c : (q == 2) ? -s : -c;
    cs = (q == 0) ? c : (q == 1) ? -s : (q == 2) ? -c : s;
}

template <bool OUT8 = false> __device__ __forceinline__ void transpose_item(const float* W, int K, int N, void* WTv, int mode, int F, LAS float* scr, int item, int lane) {
    const int nblk = N / 32, kb = item / nblk, nb = item % nblk, k0 = 64 * kb, n0 = 32 * nb;
    int rout = n0;
    if (mode == 1) { if (n0 < F) rout = 256 * (n0 / 128) + (n0 % 128); else { const int n1 = n0 - F; rout = 256 * (n1 / 128) + 128 + (n1 % 128); } }
    if (mode == 2) {
        const int hf = (n0 >> 5) & 1;
        if (n0 < 512) { const int h = n0 >> 6; rout = 256 * (h >> 2) + 32 * (h & 3) + 128 * hf; }
        else if (n0 < 640) { const int g2 = (n0 - 512) >> 6; rout = 512 + 32 * g2 + 128 * hf; }
        else if (n0 < 768) { const int g2 = (n0 - 640) >> 6; rout = 576 + 32 * g2 + 128 * hf; } }
#pragma unroll 8
    for (int i = 0; i < 32; ++i) { const int kk = 2 * i + (lane >> 5); scr[kk * 33 + (lane & 31)] = __builtin_nontemporal_load(W + (size_t)(k0 + kk) * N + n0 + (lane & 31)); }
    asm volatile("s_waitcnt lgkmcnt(0)" ::: "memory");
    const int c = lane & 7;
#pragma unroll
    for (int j = 0; j < 4; ++j) { const int n = (lane >> 3) + 8 * j; const LAS float* s = scr + (8 * c) * 33 + n;
        if constexpr (OUT8) { u32x2 o; o.x = cvt4_fp8(s[0 * 33] * W8_SCALE, s[1 * 33] * W8_SCALE, s[2 * 33] * W8_SCALE, s[3 * 33] * W8_SCALE); o.y = cvt4_fp8(s[4 * 33] * W8_SCALE, s[5 * 33] * W8_SCALE, s[6 * 33] * W8_SCALE, s[7 * 33] * W8_SCALE);
            *(u32x2*)((unsigned char*)WTv + (size_t)(rout + n) * K + k0 + 8 * c) = o; }
        else { u32x4 o; o.x = cvtpk(s[0 * 33], s[1 * 33]); o.y = cvtpk(s[2 * 33], s[3 * 33]); o.z = cvtpk(s[4 * 33], s[5 * 33]); o.w = cvtpk(s[6 * 33], s[7 * 33]);
            *(u32x4*)((bf16_t*)WTv + (size_t)(rout + n) * K + k0 + 8 * c) = o; } }
    asm volatile("s_waitcnt lgkmcnt(0)" ::: "memory");
}

__device__ __forceinline__ void row_load(f32x4 (&v)[4], const float* xrow, int lane) { const f32x4* xr = (const f32x4*)xrow + lane;
#pragma unroll
    for (int j = 0; j < 4; ++j) v[j] = __builtin_nontemporal_load(xr + 64 * j); }
__device__ __forceinline__ void row_load(f32x4 (&v)[4], const bf16_t* xrow, int lane) { const u32x2* xr = (const u32x2*)xrow + lane;
#pragma unroll
    for (int j = 0; j < 4; ++j) { const u32x2 w = __builtin_nontemporal_load(xr + 64 * j); v[j] = (f32x4){bflo(w.x), bfhi(w.x), bflo(w.y), bfhi(w.y)}; } }
template <bool OUT8 = false> __device__ __forceinline__ void normmod_row(const f32x4 (&v)[4], const float* g, const float* shift, const float* scale, void* orow, int lane, f32x4 (&hv)[4]) {
    float s = 0.f;
#pragma unroll
    for (int j = 0; j < 4; ++j) { s += (v[j].x * v[j].x + v[j].y * v[j].y) + (v[j].z * v[j].z + v[j].w * v[j].w); }
    const float rstd = 1.0f / sqrtf(wave_sum(s) * (1.f / DM) + NEPS);
#pragma unroll
    for (int j = 0; j < 4; ++j) { const f32x4 gg = ((const f32x4*)g)[lane + 64 * j], sh = ((const f32x4*)shift)[lane + 64 * j], sc = ((const f32x4*)scale)[lane + 64 * j];
        hv[j] = (v[j] * rstd * gg) * (1.0f + sc) + sh;
        if constexpr (OUT8) ((unsigned*)orow)[lane + 64 * j] = cvt4_fp8(hv[j].x, hv[j].y, hv[j].z, hv[j].w);
        else { u32x2 w; w.x = cvtpk(hv[j].x, hv[j].y); w.y = cvtpk(hv[j].z, hv[j].w); ((u32x2*)orow)[lane + 64 * j] = w; } }
}

struct Args { const float* in[27]; float* out; unsigned char* ws; };
constexpr int PTR_OFF = LDSCTL_OFF + 512;
__device__ __forceinline__ const float* inptr(LAS unsigned char* lds, int i) {
    const LAS unsigned* t = (const LAS unsigned*)(lds + PTR_OFF) + 2 * i; const unsigned lo = __builtin_amdgcn_readfirstlane(t[0]), hi = __builtin_amdgcn_readfirstlane(t[1]);
    return (const float*)(GAS const float*)(((unsigned long long)hi << 32) | (unsigned long long)lo);
}
#define INP(i) inptr(lds, (i))
#define WSB(name) GAS unsigned char* name = (GAS unsigned char*)wsbase; asm volatile("" : "+s"(name))
#define FRESH_IDS() int tid_l = threadIdx.x; asm volatile("" : "+v"(tid_l)); const int tid = tid_l, lane = tid & 63; (void)tid; (void)lane
#define GRID_BAR() do { XcdBarrier b_; GAS unsigned char* w_ = (GAS unsigned char*)wsbase; asm volatile("" : "+s"(w_)); b_.bar = (unsigned*)(w_ + WS_CTL) + CW_BAR; b_.x = xb_xcc_id(); b_.st = (volatile LAS unsigned*)(lds + MISC_OFF) + 8; xcd_barrier(b_); } while (0)
enum { I_X = 0, I_C, I_CTX, I_CCTX, I_WMOD, I_BMOD, I_GATTN, I_GFFN, I_WIN, I_WOUT, I_GQ, I_GK, I_LQ1, I_LK1, I_LQ2, I_LK2, I_GSUB, I_GCQ, I_GCKV, I_WUQ, I_WUKV, I_FWIN, I_FWOUT, I_ROUTER, I_MWIN, I_MWOUT, I_GFINAL };

template <int l> __device__ __forceinline__ void layer_body(unsigned char* wsbase, float* outbase, LAS unsigned char* lds, const int G, const int vcu, const int wave) {
    const int gw = vcu * NWAVES + wave, NGW = G * NWAVES;
        if (l == 0) {
            FRESH_IDS(); WSB(ws);
            const float* modl = (const float*)(ws + WS_MODV) + (size_t)l * 9 * 6144; bf16_t* HB = (bf16_t*)(ws + WS_H);
            const float* x_in = INP(I_X); const float* ctx_in = INP(I_CTX); const float* g_attn = INP(I_GATTN) + l * DM;
#define P1_SRC(r_) (((r_) % TROWS) < CTX ? ctx_in + ((size_t)((r_) / TROWS) * CTX + ((r_) % TROWS)) * DM : x_in + ((size_t)((r_) / TROWS) * SEQ + (((r_) % TROWS) - CTX)) * DM)
            f32x4 nv[4]; if (gw < MROWS) row_load(nv, P1_SRC(gw), lane);
            for (int r = gw; r < MROWS; r += NGW) {
                const int b = r / TROWS, j = r % TROWS;
                f32x4 v[4];
#pragma unroll
                for (int q = 0; q < 4; ++q) v[q] = nv[q];
                if (r + NGW < MROWS) row_load(nv, P1_SRC(r + NGW), lane);
                const float* mr = modl + (size_t)(j < CTX ? 8 : b) * 6144;
                f32x4 hv[4]; normmod_row(v, g_attn, mr, mr + DM, HB + (size_t)r * DM, lane, hv);
            }
#undef P1_SRC
        } else if ((int)blockIdx.x < 32) {
            const int c = (int)blockIdx.x, b = c & 7, pn = c >> 3;
            {
                WSB(ws);
                pg8::Gemm g{(const bf16_t*)(ws + WS_ACT8), (const bf16_t*)(ws + WS_FOUT8), DFF, DFF}; pg8::CtxOrder S{c, 1};
                pg8::EpiRes<true> E{nullptr, nullptr, (bf16_t*)(ws + WS_X), (const float*)(ws + WS_MODV), 5, W8_INV, TPB};
                pg8::gemm_phase<pg8::EpiRes<true>, pg8::CtxOrder, true, 1>(lds, g, S, E);
            }
            { WSB(ws); ctx_handoff((unsigned*)(ws + WS_CTL), 8 + b); }
            {
                FRESH_IDS(); WSB(ws);
                const float* mr = (const float*)(ws + WS_MODV) + (size_t)l * 9 * 6144 + (size_t)8 * 6144; const bf16_t* XW = (const bf16_t*)(ws + WS_X); bf16_t* HB = (bf16_t*)(ws + WS_H); const float* g_attn = INP(I_GATTN) + l * DM;
                const size_t r0 = (size_t)b * TROWS + 64 * pn + wave * 8;
                f32x4 nv[4]; row_load(nv, XW + r0 * DM, lane);
                for (int i = 0; i < 8; ++i) {
                    f32x4 v[4];
#pragma unroll
                    for (int q = 0; q < 4; ++q) v[q] = nv[q];
                    if (i + 1 < 8) row_load(nv, XW + (r0 + i + 1) * DM, lane);
                    f32x4 hv[4]; normmod_row(v, g_attn, mr, mr + DM, HB + (r0 + i) * DM, lane, hv);
                }
            }
        } else {
            FRESH_IDS(); WSB(ws);
            const float* modl = (const float*)(ws + WS_MODV) + (size_t)l * 9 * 6144; const bf16_t* XW = (const bf16_t*)(ws + WS_X); bf16_t* HB = (bf16_t*)(ws + WS_H); const float* g_attn = INP(I_GATTN) + l * DM;
            const int gwl = ((int)blockIdx.x - 32) * NWAVES + wave, NGL = (G - 32) * NWAVES;
#define P1_ROW(t_) ((size_t)((t_) / SEQ) * TROWS + CTX + ((t_) % SEQ))
            f32x4 nv[4]; if (gwl < NTOK) row_load(nv, XW + P1_ROW(gwl) * DM, lane);
            for (int tk = gwl; tk < NTOK; tk += NGL) {
                const int b = tk / SEQ; const size_t r = P1_ROW(tk);
                f32x4 v[4];
#pragma unroll
                for (int q = 0; q < 4; ++q) v[q] = nv[q];
                if (tk + NGL < NTOK) row_load(nv, XW + P1_ROW(tk + NGL) * DM, lane);
                const float* mr = modl + (size_t)b * 6144;
                f32x4 hv[4]; normmod_row(v, g_attn, mr, mr + DM, HB + r * DM, lane, hv);
            }
#undef P1_ROW
        }
        GRID_BAR();
        {
            WSB(ws);
            pg8::Gemm g{(const bf16_t*)(ws + WS_H), (const bf16_t*)(ws + WS_WIN) + (size_t)l * 2048 * DM, DM, DM}; pg8::MapOrder<0> S; S.so.init(MROWS / 256, 7, G, (int)blockIdx.x);
            LAS float* bslot = (LAS float*)(lds + LDSCTL_OFF + 1024);
            { int t0_ = threadIdx.x; asm volatile("" : "+v"(t0_)); if (t0_ < 32) bslot[t0_] = 0.f; }
            __syncthreads();
            pg8::EpiIn E{(bf16_t*)(ws + WS_P), (float*)(ws + WS_MS), (const f32x2*)(ws + WS_ROPEA), (const f32x2*)(ws + WS_ROPEB), INP(I_GQ) + l * 64, INP(I_GK) + l * 64, bslot, (bf16_t*)(ws + WS_KTG)};
            pg8::gemm_phase<pg8::EpiIn, pg8::MapOrder<0>, true>(lds, g, S, E);
            { pg8::TailOrder T; T.init(MROWS / 256, 7, G, (int)blockIdx.x, (MROWS / 256) * 7); pg8::gemm_phase<pg8::EpiIn, pg8::TailOrder, true, 2, true>(lds, g, T, E); }
            __syncthreads();
            { int t1_ = threadIdx.x; asm volatile("" : "+v"(t1_)); if (t1_ < 3) { float m = 0.f; for (int w = 0; w < NWAVES; ++w) m = fmaxf(m, bslot[w * 4 + t1_]); ((float*)(ws + WS_BND))[((size_t)l * 1024 + blockIdx.x) * 8 + t1_] = m; } }
            __syncthreads();
        }
        GRID_BAR();
        {
            WSB(ws);
            pg8::Gemm gq{(const bf16_t*)(ws + WS_P) + 1536, (const bf16_t*)(ws + WS_WU) + (size_t)l * 512 * 256, PW, 256}; pg8::Gemm gkv{(const bf16_t*)(ws + WS_P) + 1664, (const bf16_t*)(ws + WS_WUKV) + (size_t)l * 512 * 256, PW, 256};
            LAS float* bslot = (LAS float*)(lds + LDSCTL_OFF + 1024);
            if (threadIdx.x < 16) bslot[threadIdx.x] = 0.f;
            __syncthreads();
            pg8::EpiMla Eq{(bf16_t*)(ws + WS_QM), (bf16_t*)(ws + WS_KN), (bf16_t*)(ws + WS_VM), (const float*)(ws + WS_MS), bslot, 0, 384};
            pg8::EpiMla Ekv{(bf16_t*)(ws + WS_QM), (bf16_t*)(ws + WS_KN), (bf16_t*)(ws + WS_VM), (const float*)(ws + WS_MS), bslot, 384, 896};
            constexpr int NMT = MROWS / 256;
            { pg8::RotOrder S; S.init(NMT, 1, 0, G, (int)blockIdx.x, 0); pg8::gemm_phase<pg8::EpiMla, pg8::RotOrder, true>(lds, gq, S, Eq); }
            { pg8::RotOrder S; S.init(NMT, 2, 0, G, (int)blockIdx.x, NMT % G); pg8::gemm_phase<pg8::EpiMla, pg8::RotOrder, true>(lds, gkv, S, Ekv); }
            { pg8::RotOrder S; S.init(NMT, 1, 1, G, (int)blockIdx.x, (3 * NMT) % G); pg8::gemm_phase<pg8::EpiMla, pg8::RotOrder, true, 2, true>(lds, gq, S, Eq); }
            __syncthreads();
            if (threadIdx.x < 2) { float m = 0.f; for (int w = 0; w < NWAVES; ++w) m = fmaxf(m, bslot[w * 2 + threadIdx.x]); ((float*)(ws + WS_BND))[((size_t)l * 1024 + blockIdx.x) * 8 + 3 + threadIdx.x] = m; }
        }
        GRID_BAR();
        {
            WSB(ws);
            bf16_t* PB = (bf16_t*)(ws + WS_P); bf16_t* HB = (bf16_t*)(ws + WS_H); bf16_t* QM = (bf16_t*)(ws + WS_QM); bf16_t* KN = (bf16_t*)(ws + WS_KN); bf16_t* VM = (bf16_t*)(ws + WS_VM); const bf16_t* KTG = (const bf16_t*)(ws + WS_KTG);
            const float lam = ((const float*)(ws + WS_LAM))[l]; const float oml = 1.0f - (l == 0 ? 0.2f : 0.35550906759096934f); const float* d_gsub = INP(I_GSUB) + l * 64;
            const int per_b = 256 + (l == 0 ? 16 : 0), nrd = (per_b + 31) / 32, total = nrd * 256;
            bool gqa_nomax;
            { const float* gq_ = INP(I_GQ) + l * 64; const float* gk_ = INP(I_GK) + l * 64; float mq = 0.f, mk = 0.f;
              for (int i = 0; i < 64; ++i) { mq = fmaxf(mq, fabsf(gq_[i])); mk = fmaxf(mk, fabsf(gk_[i])); }
              gqa_nomax = __builtin_amdgcn_readfirstlane((int)(64.0f * SC_G * mq * mk < 60.0f)) != 0; }
            bool dif_nomax, mla_nomax;
            { FRESH_IDS(); const float* bnd = (const float*)(ws + WS_BND) + (size_t)l * 1024 * 8; float m[5] = {0.f, 0.f, 0.f, 0.f, 0.f};
              for (int w = tid; w < G; w += NWAVES * 64) {
#pragma unroll
                  for (int k = 0; k < 5; ++k) m[k] = fmaxf(m[k], bnd[(size_t)w * 8 + k]); }
              LAS float* red = (LAS float*)lds;
#pragma unroll
              for (int k = 0; k < 5; ++k) { const float v = wave_max(m[k]); if (lane == 0) red[wave * 8 + k] = v; }
              __syncthreads();
              float t[5];
#pragma unroll
              for (int k = 0; k < 5; ++k) { float v = 0.f; for (int w = 0; w < NWAVES; ++w) v = fmaxf(v, red[w * 8 + k]); t[k] = v; }
              __syncthreads();
              const float bd = sqrtf(t[0] * t[1]) * 1.02f, bm = sqrtf(3.0f * t[3] * (2.0f * t[4] + t[2])) * 1.02f;
              dif_nomax = __builtin_amdgcn_readfirstlane((int)(bd < 90.0f)) != 0; mla_nomax = __builtin_amdgcn_readfirstlane((int)(bm < 90.0f)) != 0; }
            for (int U = vcu; U < total; U += G) {
                const int cl = U % 32, xb = (U / 32) % NB, rd = U / 256;
                const int jj = rd * 32 + cl; if (jj >= per_b) continue;
                int kind, hd, qb;
                if (jj < 128) { kind = 0; hd = jj >> 4; qb = (jj & 15) + 1; } else if (jj < 192) { kind = 1; hd = (jj - 128) >> 4; qb = (jj & 15) + 1; } else if (jj < 256) { kind = 2; hd = (jj - 192) >> 4; qb = (jj & 15) + 1; }
                else { const int c = jj - 256; qb = 0; if (c < 8) { kind = 0; hd = c; } else if (c < 12) { kind = 1; hd = c - 8; } else { kind = 2; hd = c - 12; } }
                const size_t rb = (size_t)xb * TROWS, rq = rb + (size_t)qb * 256;
                const int NT = qb == 0 ? CTX / 64 : TROWS / 64;
                if (kind == 0) {
                    if (gqa_nomax) attn_body::attn_unit<8, 0, 0, 64, true, 128, true>((const attn_body::bf16*)(PB + rq * PW + (hd >> 2) * 256 + (hd & 3) * 32), PW, (const attn_body::bf16*)(KTG + ((size_t)(hd >> 2) * (MROWS / 64) + rb / 64) * 4096), PW, (const attn_body::bf16*)(PB + rb * PW + 576 + (hd >> 2) * 32), PW, (attn_body::bf16*)(HB + rq * DM + hd * 64), DM, NT, (char*)lds, 0.f, 0.f, d_gsub);
                    else attn_body::attn_unit<8, 0, 0, 64, false, 128, true>((const attn_body::bf16*)(PB + rq * PW + (hd >> 2) * 256 + (hd & 3) * 32), PW, (const attn_body::bf16*)(KTG + ((size_t)(hd >> 2) * (MROWS / 64) + rb / 64) * 4096), PW, (const attn_body::bf16*)(PB + rb * PW + 576 + (hd >> 2) * 32), PW, (attn_body::bf16*)(HB + rq * DM + hd * 64), DM, NT, (char*)lds, 0.f, 0.f, d_gsub); }
                else if (kind == 1) {
                    if (dif_nomax) { attn_body::attn_unit<8, 1, 1, 64, true>((const attn_body::bf16*)(PB + rq * PW + PC_DQ + hd * 64), PW, (const attn_body::bf16*)(PB + rb * PW + PC_DK + hd * 64), PW, (const attn_body::bf16*)(PB + rb * PW + PC_DV + hd * 64), PW, (attn_body::bf16*)(HB + rq * DM + 512 + hd * 64), DM, NT, (char*)lds, lam, oml, d_gsub);
                                     attn_body::attn_unit<8, 2, 2, 64, true>((const attn_body::bf16*)(PB + rq * PW + PC_DQ + hd * 64), PW, (const attn_body::bf16*)(PB + rb * PW + PC_DK + hd * 64), PW, (const attn_body::bf16*)(PB + rb * PW + PC_DV + hd * 64), PW, (attn_body::bf16*)(HB + rq * DM + 512 + hd * 64), DM, NT, (char*)lds, lam, oml, d_gsub); }
                    else { attn_body::attn_unit<8, 1, 1>((const attn_body::bf16*)(PB + rq * PW + PC_DQ + hd * 64), PW, (const attn_body::bf16*)(PB + rb * PW + PC_DK + hd * 64), PW, (const attn_body::bf16*)(PB + rb * PW + PC_DV + hd * 64), PW, (attn_body::bf16*)(HB + rq * DM + 512 + hd * 64), DM, NT, (char*)lds, lam, oml, d_gsub);
                           attn_body::attn_unit<8, 2, 2>((const attn_body::bf16*)(PB + rq * PW + PC_DQ + hd * 64), PW, (const attn_body::bf16*)(PB + rb * PW + PC_DK + hd * 64), PW, (const attn_body::bf16*)(PB + rb * PW + PC_DV + hd * 64), PW, (attn_body::bf16*)(HB + rq * DM + 512 + hd * 64), DM, NT, (char*)lds, lam, oml, d_gsub); } }
                else {
                    if (mla_nomax) attn_body::attn_unit<8, 0, 0, 96, true>((const attn_body::bf16*)(QM + rq * 384 + hd * 96), 384, (const attn_body::bf16*)(KN + rb * 256 + hd * 64), 256, (const attn_body::bf16*)(VM + rb * 256 + hd * 64), 256, (attn_body::bf16*)(HB + rq * DM + 768 + hd * 64), DM, NT, (char*)lds, 0.f, 0.f, d_gsub,
                        (const attn_body::bf16*)(PB + rb * PW + PC_KR), PW, (const attn_body::f32x2_t*)(ws + WS_ROPEB), qb == 0 ? -1 : (qb - 1) * 256);
                    else attn_body::attn_unit<8, 0, 0, 96>((const attn_body::bf16*)(QM + rq * 384 + hd * 96), 384, (const attn_body::bf16*)(KN + rb * 256 + hd * 64), 256, (const attn_body::bf16*)(VM + rb * 256 + hd * 64), 256, (attn_body::bf16*)(HB + rq * DM + 768 + hd * 64), DM, NT, (char*)lds, 0.f, 0.f, d_gsub,
                        (const attn_body::bf16*)(PB + rb * PW + PC_KR), PW, (const attn_body::f32x2_t*)(ws + WS_ROPEB), qb == 0 ? -1 : (qb - 1) * 256); }
            }
        }
        GRID_BAR();
        if (l == 0) {
            WSB(ws);
            pg8::Gemm g{(const bf16_t*)(ws + WS_H), (const bf16_t*)(ws + WS_WOUT), DM, DM}; pg8::MapOrder<1> S; S.so.init(NTOK / 256, 4, G, (int)blockIdx.x);
            pg8::EpiRes<false> E{INP(I_X), INP(I_CTX), (bf16_t*)(ws + WS_X), (const float*)(ws + WS_MODV), 2, 1.0f, 1};
            pg8::gemm_phase<pg8::EpiRes<false>, pg8::MapOrder<1>, true>(lds, g, S, E);
        } else {
            WSB(ws);
            pg8::Gemm g{(const bf16_t*)(ws + WS_H), (const bf16_t*)(ws + WS_WOUT) + (size_t)DM * DM, DM, DM}; pg8::MapOrder<1> S; S.so.init(NTOK / 256, 4, G, (int)blockIdx.x);
            pg8::EpiRes<true> E{nullptr, nullptr, (bf16_t*)(ws + WS_X), (const float*)(ws + WS_MODV) + (size_t)9 * 6144, 2, 1.0f, 1};
            pg8::gemm_phase<pg8::EpiRes<true>, pg8::MapOrder<1>, true>(lds, g, S, E);
        }
        GRID_BAR();
        if (l == 0) {
            if ((int)blockIdx.x < 32) {
                const int c = (int)blockIdx.x, b = c & 7, pn = c >> 3;
                {
                    WSB(ws);
                    pg8::Gemm g{(const bf16_t*)(ws + WS_H), (const bf16_t*)(ws + WS_WOUT), DM, DM}; pg8::CtxOrder S{c, TPB};
                    pg8::EpiRes<false> E{INP(I_X), INP(I_CTX), (bf16_t*)(ws + WS_X), (const float*)(ws + WS_MODV), 2, 1.0f, 1};
                    pg8::gemm_phase<pg8::EpiRes<false>, pg8::CtxOrder, true>(lds, g, S, E);
                }
                { WSB(ws); ctx_handoff((unsigned*)(ws + WS_CTL), b); }
                {
                    FRESH_IDS(); WSB(ws);
                    const float* mr = (const float*)(ws + WS_MODV) + (size_t)8 * 6144; const bf16_t* XW = (const bf16_t*)(ws + WS_X); const float* g_ffn = INP(I_GFFN);
                    const int j0 = 64 * pn + wave * 8; const size_t r0 = (size_t)b * TROWS + j0;
                    f32x4 nv[4]; row_load(nv, XW + r0 * DM, lane);
                    for (int i = 0; i < 8; ++i) {
                        f32x4 v[4];
#pragma unroll
                        for (int q = 0; q < 4; ++q) v[q] = nv[q];
                        if (i + 1 < 8) row_load(nv, XW + (r0 + i + 1) * DM, lane);
                        f32x4 hv[4]; normmod_row<true>(v, g_ffn, mr + 3 * DM, mr + 4 * DM, (unsigned char*)(ws + WS_H8) + ((size_t)b * CTX + j0 + i) * DM, lane, hv);
                    }
                }
            } else {
                FRESH_IDS(); WSB(ws);
                const float* modl = (const float*)(ws + WS_MODV); const bf16_t* XW = (const bf16_t*)(ws + WS_X); const float* g_ffn = INP(I_GFFN);
                const int gwl = ((int)blockIdx.x - 32) * NWAVES + wave, NGL = (G - 32) * NWAVES;
#define P8_ROW(t_) ((size_t)((t_) / SEQ) * TROWS + CTX + ((t_) % SEQ))
                f32x4 nv[4]; if (gwl < NTOK) row_load(nv, XW + P8_ROW(gwl) * DM, lane);
                for (int tk = gwl; tk < NTOK; tk += NGL) {
                    const int b = tk / SEQ; const size_t r = P8_ROW(tk); const float* mr = modl + (size_t)b * 6144;
                    f32x4 v[4];
#pragma unroll
                    for (int q = 0; q < 4; ++q) v[q] = nv[q];
                    if (tk + NGL < NTOK) row_load(nv, XW + P8_ROW(tk + NGL) * DM, lane);
                    f32x4 hv[4]; normmod_row<true>(v, g_ffn, mr + 3 * DM, mr + 4 * DM, (unsigned char*)(ws + WS_QM) + r * DM, lane, hv);
                }
#undef P8_ROW
            }
            GRID_BAR();
            {
                WSB(ws);
                {
                    pg8::Gemm g{(const bf16_t*)(ws + WS_QM), (const bf16_t*)(ws + WS_FIN8), DM, DM}; pg8::MapOrder<1> S; S.so.init(NTOK / 256, 22, G, (int)blockIdx.x);
                    pg8::EpiSwiglu<false, true> E{(void*)(ws + WS_ACT), DFF, 22, 0};
                    pg8::gemm_phase<pg8::EpiSwiglu<false, true>, pg8::MapOrder<1>, true, 1>(lds, g, S, E);
                }
                {
                    pg8::Gemm g{(const bf16_t*)(ws + WS_H8), (const bf16_t*)(ws + WS_FIN8), DM, DM}; pg8::MapOrder<0> S; S.so.init(NB, 22, G, (int)blockIdx.x);
                    pg8::EpiSwiglu<true> E{(void*)(ws + WS_ACT8), DFF, 22, 0};
                    pg8::gemm_phase<pg8::EpiSwiglu<true>, pg8::MapOrder<0>, true, 1>(lds, g, S, E);
                }
            }
            GRID_BAR();
            {
                WSB(ws);
                {
                    pg8::Gemm g{(const bf16_t*)(ws + WS_ACT), (const bf16_t*)(ws + WS_FOUT), DFF, DFF}; pg8::MapOrder<1> S; S.so.init(NTOK / 256, 4, G, (int)blockIdx.x);
                    pg8::EpiRes<true> E{nullptr, nullptr, (bf16_t*)(ws + WS_X), (const float*)(ws + WS_MODV), 5, 1.0f, 1};
                    pg8::gemm_phase<pg8::EpiRes<true>, pg8::MapOrder<1>, true>(lds, g, S, E);
                }
            }
            GRID_BAR();
        } else {
            {
                FRESH_IDS(); WSB(ws);
                const float* modl = (const float*)(ws + WS_MODV) + (size_t)9 * 6144; const bf16_t* XW = (const bf16_t*)(ws + WS_X); bf16_t* HB = (bf16_t*)(ws + WS_H);
                int* tok_e = (int*)(ws + WS_TOKE); float* tok_w = (float*)(ws + WS_TOKW); unsigned* ctl = (unsigned*)(ws + WS_CTL);
                const float* g_ffn = INP(I_GFFN) + DM; const float* moe_router = INP(I_ROUTER);
                LAS float* wrT = (LAS float*)lds;
                LAS unsigned* hist = (LAS unsigned*)(lds + 32768);
                for (int i = tid; i < NEXP * DM; i += NWAVES * 64) { const int e = i / DM, k = i % DM; wrT[i] = moe_router[k * NEXP + e]; }
                if (tid < NEXP) hist[tid] = 0u;
                __syncthreads();
#define TK_ROW(t_) ((size_t)((t_) / SEQ) * TROWS + CTX + ((t_) % SEQ))
                f32x4 nv[4]; if (gw < NTOK) row_load(nv, XW + TK_ROW(gw) * DM, lane);
                for (int tk = gw; tk < NTOK; tk += NGW) {
                    const int b = tk / SEQ; const size_t r = TK_ROW(tk); const float* mr = modl + (size_t)b * 6144;
                    f32x4 v[4];
#pragma unroll
                    for (int q = 0; q < 4; ++q) v[q] = nv[q];
                    if (tk + NGW < NTOK) row_load(nv, XW + TK_ROW(tk + NGW) * DM, lane);
                    f32x4 hv[4]; normmod_row<true>(v, g_ffn, mr + 3 * DM, mr + 4 * DM, (unsigned char*)HB + r * DM, lane, hv);
                    float lg[NEXP];
#pragma unroll
                    for (int e = 0; e < NEXP; ++e) { float sacc = 0.f;
#pragma unroll
                        for (int j = 0; j < 4; ++j) { const f32x4 w = ((const LAS f32x4*)(wrT + e * DM))[lane + 64 * j]; sacc += (hv[j].x * w.x + hv[j].y * w.y) + (hv[j].z * w.z + hv[j].w * w.w); }
                        lg[e] = wave_sum(sacc); }
                    int e0 = 0; float v0 = lg[0];
#pragma unroll
                    for (int e = 1; e < NEXP; ++e) if (lg[e] > v0) { v0 = lg[e]; e0 = e; }
                    int e1 = -1; float v1 = -3.0e38f;
#pragma unroll
                    for (int e = 0; e < NEXP; ++e) if (e != e0 && lg[e] > v1) { v1 = lg[e]; e1 = e; }
                    if (lane == 0) { const float w1 = 1.0f / (1.0f + expf(v0 - v1)); tok_e[2 * tk] = e0; tok_e[2 * tk + 1] = e1; tok_w[2 * tk] = 1.0f - w1; tok_w[2 * tk + 1] = w1;
                        __hip_atomic_fetch_add(&hist[e0], 1u, __ATOMIC_RELAXED, __HIP_MEMORY_SCOPE_WORKGROUP); __hip_atomic_fetch_add(&hist[e1], 1u, __ATOMIC_RELAXED, __HIP_MEMORY_SCOPE_WORKGROUP); }
                }
                __syncthreads();
                if (tid < NEXP && hist[tid]) atomicAdd(ctl + CW_CNT + 64 * tid, hist[tid]);
                __syncthreads();
                const float* moe_w_in = INP(I_MWIN); const float* moe_w_out = INP(I_MWOUT); bf16_t* Min_t = (bf16_t*)(ws + WS_MIN); bf16_t* Mout_t = (bf16_t*)(ws + WS_MOUT);
                LAS float* scr = (LAS float*)(lds + wave * 16384);
                constexpr int N_MIN = 16 * 112, N_MOUT = 28 * 32;
                for (int it = gw; it < NEXP * (N_MIN + N_MOUT); it += NGW) {
                    const int e = it / (N_MIN + N_MOUT), r = it % (N_MIN + N_MOUT);
                    if (r < N_MIN) transpose_item<true>(moe_w_in + (size_t)e * DM * 2 * DFE, DM, 2 * DFE, (unsigned char*)Min_t + (size_t)e * 2 * DFE * DM, 1, DFE, scr, r, lane);
                    else transpose_item<true>(moe_w_out + (size_t)e * DFE * DM, DFE, DM, (unsigned char*)Mout_t + (size_t)e * DM * DFE, 0, 0, scr, r - N_MIN, lane);
                }
            }
            GRID_BAR();
            int ntiles;
            {
                FRESH_IDS(); WSB(ws);
                unsigned* ctl = (unsigned*)(ws + WS_CTL); const int* tok_e = (const int*)(ws + WS_TOKE); int* tok_s = (int*)(ws + WS_TOKS); int* tile_e = (int*)(ws + WS_TILEE);
                const bf16_t* HB = (const bf16_t*)(ws + WS_H); unsigned char* AMOE8 = (unsigned char*)(ws + WS_AMOE8);
                LAS unsigned* lcnt = (LAS unsigned*)lds; LAS unsigned* lbase = lcnt + 8; LAS int* lsrc = (LAS int*)(lds + 64); LAS int* ldst = (LAS int*)(lds + 64 + 1024);
                unsigned cnt[NEXP], segb[NEXP]; unsigned accb = 0;
#pragma unroll
                for (int e = 0; e < NEXP; ++e) { cnt[e] = xb_ld(ctl + CW_CNT + 64 * e); segb[e] = accb; accb += ((cnt[e] + 255u) / 256u) * 256u; }
                ntiles = __builtin_amdgcn_readfirstlane((int)(accb / 256u));
                if (blockIdx.x == 0) { for (int ti = tid; ti < ntiles; ti += NWAVES * 64) { int e = 0;
#pragma unroll
                        for (int q = 1; q < NEXP; ++q) if ((unsigned)ti * 256u >= segb[q]) e = q;
                        tile_e[ti] = e; } }
                for (int chunk = vcu; chunk < NTOK / 128; chunk += G) {
                    if (tid < NEXP) lcnt[tid] = 0u;
                    __syncthreads();
                    int e = 0, tk = 0, kk = 0; unsigned pos = 0;
                    if (tid < 256) { tk = chunk * 128 + (tid >> 1); kk = tid & 1; e = tok_e[2 * tk + kk]; pos = __hip_atomic_fetch_add(&lcnt[e], 1u, __ATOMIC_RELAXED, __HIP_MEMORY_SCOPE_WORKGROUP); }
                    __syncthreads();
                    if (tid < NEXP) lbase[tid] = lcnt[tid] ? atomicAdd(ctl + CW_FILL + 64 * tid, lcnt[tid]) : 0u;
                    __syncthreads();
                    if (tid < 256) { unsigned sb = 0;
#pragma unroll
                        for (int q = 0; q < NEXP; ++q) sb = (e == q) ? segb[q] : sb;
                        const int slot = (int)(sb + lbase[e] + pos); tok_s[2 * tk + kk] = slot; ldst[tid] = slot; const int b = tk / SEQ, s = tk % SEQ; lsrc[tid] = b * TROWS + CTX + s; }
                    __syncthreads();
                    for (int i0 = wave * 32; i0 < wave * 32 + 32; i0 += 4) { u32x4 va[4], vb[4];
#pragma unroll
                        for (int q = 0; q < 4; ++q) { const u32x4* sp = (const u32x4*)((const unsigned char*)HB + (size_t)lsrc[i0 + q] * DM); va[q] = sp[lane]; }
#pragma unroll
                        for (int q = 0; q < 4; ++q) { u32x4* dp = (u32x4*)((unsigned char*)AMOE8 + (size_t)ldst[i0 + q] * DM); dp[lane] = va[q]; } (void)vb; }
                    __syncthreads();
                }
            }
            GRID_BAR();
            {
                const int t0 = 0; const int nt_c = ntiles;
                {
                    WSB(ws);
                    pg8::Gemm g{(const bf16_t*)(ws + WS_AMOE8), (const bf16_t*)(ws + WS_MIN), DM, DM}; pg8::MapOrder<2> S; S.so.init(nt_c, 14, G, (int)blockIdx.x); S.t0 = t0; S.nct = 14; S.tile_e = (const int*)(ws + WS_TILEE);
                    pg8::EpiSwiglu<true> E{(void*)(ws + WS_ACTC), DFE, 14, t0};
                    pg8::gemm_phase<pg8::EpiSwiglu<true>, pg8::MapOrder<2>, true, 1>(lds, g, S, E);
                }
                GRID_BAR();
                {
                    WSB(ws);
                    const int ntot = nt_c * 4, nfull_ = (ntot / G) * G, nfull = (2 * (ntot - nfull_) <= G) ? nfull_ : ntot;
                    pg8::Gemm g{(const bf16_t*)(ws + WS_ACTC), (const bf16_t*)(ws + WS_MOUT), DFE, DFE}; pg8::MapOrder<3> S; S.so.init(nt_c, 4, G, (int)blockIdx.x); S.so.nwg = nfull; S.t0 = t0; S.nct = 4; S.tile_e = (const int*)(ws + WS_TILEE);
                    pg8::EpiBf16 E{(bf16_t*)(ws + WS_AMOE), DM, DM, 4, t0, W8_INV};
                    pg8::gemm_phase<pg8::EpiBf16, pg8::MapOrder<3>, true, 1>(lds, g, S, E);
                    if (nfull < ntot) {
                        pg8::MoeTailOrder T; T.so.init(nt_c, 4, G, (int)blockIdx.x); T.nfull = nfull; T.ntot = ntot; T.c = (int)blockIdx.x; T.nct = 4; T.tile_e = (const int*)(ws + WS_TILEE);
                        pg8::EpiBf16H EH{(bf16_t*)(ws + WS_AMOE), DM, 4, t0, W8_INV};
                        pg8::gemm_phase<pg8::EpiBf16H, pg8::MoeTailOrder, true, 1, true>(lds, g, T, EH);
                    }
                }
                GRID_BAR();
            }
            {
                FRESH_IDS(); WSB(ws);
                const float* modl = (const float*)(ws + WS_MODV) + (size_t)9 * 6144; const bf16_t* XW = (const bf16_t*)(ws + WS_X); const bf16_t* AMOE = (const bf16_t*)(ws + WS_AMOE);
                const int* tok_s = (const int*)(ws + WS_TOKS); const float* tok_w = (const float*)(ws + WS_TOKW); const float* g_final = INP(I_GFINAL);
                GAS float* outp = (GAS float*)outbase; asm volatile("" : "+s"(outp));
                f32x4 nv[4]; u32x2 nya[4], nyc[4]; float nw0 = 0.f, nw1 = 0.f; int ps0 = 0, ps1 = 0; float pw0 = 0.f, pw1 = 0.f;
#define FIN_LOADY(t_s0, t_s1) do { const u32x2* y0_ = (const u32x2*)(AMOE + (size_t)(t_s0) * DM) + lane; const u32x2* y1_ = (const u32x2*)(AMOE + (size_t)(t_s1) * DM) + lane; \
        _Pragma("unroll") for (int j = 0; j < 4; ++j) { nya[j] = __builtin_nontemporal_load(y0_ + 64 * j); nyc[j] = __builtin_nontemporal_load(y1_ + 64 * j); } } while (0)
                if (gw < NTOK) { row_load(nv, XW + TK_ROW(gw) * DM, lane); const int s0 = tok_s[2 * gw], s1 = tok_s[2 * gw + 1]; nw0 = tok_w[2 * gw]; nw1 = tok_w[2 * gw + 1]; FIN_LOADY(s0, s1); }
                if (gw + NGW < NTOK) { const int tn = gw + NGW; ps0 = tok_s[2 * tn]; ps1 = tok_s[2 * tn + 1]; pw0 = tok_w[2 * tn]; pw1 = tok_w[2 * tn + 1]; }
                for (int tk = gw; tk < NTOK; tk += NGW) {
                    const int b = tk / SEQ; const float* gate = modl + (size_t)b * 6144 + 5 * DM;
                    const float w0 = nw0, w1 = nw1;
                    f32x4 xq[4]; u32x2 ya_[4], yc_[4];
#pragma unroll
                    for (int q = 0; q < 4; ++q) { xq[q] = nv[q]; ya_[q] = nya[q]; yc_[q] = nyc[q]; }
                    if (tk + NGW < NTOK) { const int tn = tk + NGW; row_load(nv, XW + TK_ROW(tn) * DM, lane); FIN_LOADY(ps0, ps1); nw0 = pw0; nw1 = pw1; }
                    if (tk + 2 * NGW < NTOK) { const int t2 = tk + 2 * NGW; ps0 = tok_s[2 * t2]; ps1 = tok_s[2 * t2 + 1]; pw0 = tok_w[2 * t2]; pw1 = tok_w[2 * t2 + 1]; }
                    f32x4 v[4]; float ss = 0.f;
#pragma unroll
                    for (int j = 0; j < 4; ++j) { const f32x4 xv = xq[j]; const u32x2 a = ya_[j], c = yc_[j]; const f32x4 gv = ((const f32x4*)gate)[lane + 64 * j];
                        const f32x4 ya = (f32x4){bflo(a.x), bfhi(a.x), bflo(a.y), bfhi(a.y)}, yc = (f32x4){bflo(c.x), bfhi(c.x), bflo(c.y), bfhi(c.y)};
                        v[j] = xv + gv * (ya * w0 + yc * w1); ss += (v[j].x * v[j].x + v[j].y * v[j].y) + (v[j].z * v[j].z + v[j].w * v[j].w); }
                    const float rstd = 1.0f / sqrtf(wave_sum(ss) * (1.f / DM) + NEPS);
                    f32x4* orow = (f32x4*)(outp + (size_t)tk * DM) + lane;
#pragma unroll
                    for (int j = 0; j < 4; ++j) __builtin_nontemporal_store(v[j] * rstd * ((const f32x4*)g_final)[lane + 64 * j], orow + 64 * j);
                }
#undef FIN_LOADY
            }
        }
}

__global__ void __launch_bounds__(NWAVES * 64, 2) fwd_kernel(Args args) {
    extern __shared__ __attribute__((aligned(16))) unsigned char lds_raw[];
    LAS unsigned char* lds = (LAS unsigned char*)lds_raw;
    const int wave = __builtin_amdgcn_readfirstlane((int)threadIdx.x >> 6);
    const int G = gridDim.x; const int vcu = (G % 8 == 0) ? ((int)blockIdx.x % 8) * (G / 8) + (int)blockIdx.x / 8 : (int)blockIdx.x;
    const int gw = vcu * NWAVES + wave, NGW = G * NWAVES;
    unsigned char* const wsbase = args.ws;
    {
        FRESH_IDS();
        for (int u = tid; u < (LDS_BYTES - LDSCTL_OFF) / 4; u += NWAVES * 64) ((LAS unsigned*)(lds + LDSCTL_OFF))[u] = 0u;
        __syncthreads();
        if (tid < 27) { const unsigned long long p = (unsigned long long)args.in[tid]; LAS unsigned* t = (LAS unsigned*)(lds + PTR_OFF) + 2 * tid; t[0] = (unsigned)p; t[1] = (unsigned)(p >> 32); }
        __syncthreads();
        (void)xcd_barrier_post((unsigned*)(args.ws + WS_CTL) + CW_BAR, (volatile LAS unsigned*)(lds + MISC_OFF) + 8);
    }

    {
        FRESH_IDS(); WSB(ws);
        float* modv = (float*)(ws + WS_MODV); f32x2* ropeA = (f32x2*)(ws + WS_ROPEA); f32x2* ropeB = (f32x2*)(ws + WS_ROPEB); float* lamv = (float*)(ws + WS_LAM);
        bf16_t* Win_t = (bf16_t*)(ws + WS_WIN); bf16_t* Wout_t = (bf16_t*)(ws + WS_WOUT); bf16_t* Wu_t = (bf16_t*)(ws + WS_WU); bf16_t* Fout_t = (bf16_t*)(ws + WS_FOUT);
        {
            const float* c_in = INP(I_C); const float* cctx_in = INP(I_CCTX); const float* w_mod = INP(I_WMOD); const float* b_mod = INP(I_BMOD);
            LAS float* scs = (LAS float*)lds;
            LAS float* part = (LAS float*)(lds + 36864);
            for (int i = tid; i < 9 * DM; i += NWAVES * 64) { const int rt = i / DM, k = i % DM; const float c = rt < 8 ? c_in[rt * DM + k] : cctx_in[k]; scs[i] = c / (1.0f + __expf(-c)); }
            __syncthreads();
            for (int task = vcu; task < 192; task += G) {
                const int l = task / 96, nb = task % 96, n = nb * 64 + lane;
                const float* wp = w_mod + (size_t)l * DM * 6144 + n;
                float acc9[9];
#pragma unroll
                for (int r = 0; r < 9; ++r) acc9[r] = 0.f;
                for (int k0 = wave * 128; k0 < wave * 128 + 128; k0 += 32) { float w[32];
#pragma unroll
                    for (int u = 0; u < 32; ++u) w[u] = __builtin_nontemporal_load(wp + (size_t)(k0 + u) * 6144);
#pragma unroll
                    for (int u = 0; u < 32; ++u) {
#pragma unroll
                        for (int r = 0; r < 9; ++r) acc9[r] += scs[r * DM + k0 + u] * w[u];
                        if ((u & 3) == 3) asm volatile("" ::: "memory"); } }
#pragma unroll
                for (int r = 0; r < 9; ++r) part[(wave * 9 + r) * 64 + lane] = acc9[r];
                __syncthreads();
                for (int i = tid; i < 9 * 64; i += NWAVES * 64) { const int r = i / 64, c = i % 64; float s = 0.f;
#pragma unroll
                    for (int w = 0; w < 8; ++w) s += part[(w * 9 + r) * 64 + c];
                    modv[((size_t)l * 9 + r) * 6144 + nb * 64 + c] = s + b_mod[l * 6144 + nb * 64 + c]; }
                __syncthreads();
            }
            __syncthreads();
        }
        if (vcu == (G > 200 ? 200 : 0)) {
            const float ifA[16] = {1.000000000e+00f, 5.623413252e-01f, 3.162277660e-01f, 1.778279410e-01f, 1.000000000e-01f, 5.623413252e-02f, 3.162277660e-02f, 1.778279410e-02f, 1.000000000e-02f, 5.623413252e-03f, 3.162277660e-03f, 1.778279410e-03f, 1.000000000e-03f, 5.623413252e-04f, 3.162277660e-04f, 1.778279410e-04f};
            for (int i = tid; i < 64 * 16; i += NWAVES * 64) { const int pos = i >> 4, f = i & 15; float fr_ = 1.f;
#pragma unroll
                for (int q = 0; q < 16; ++q) fr_ = (f == q) ? ifA[q] : fr_;
                float sn, cs; sincos_small((float)pos * fr_, sn, cs); ropeA[i] = (f32x2){cs, sn}; }
            for (int i = tid; i < 64 * 8; i += NWAVES * 64) { const int pos = i >> 3, f = i & 7; float fr_ = 1.f;
#pragma unroll
                for (int q = 0; q < 8; ++q) fr_ = (f == q) ? ifA[2 * q] : fr_;
                float sn, cs; sincos_small((float)pos * fr_, sn, cs); ropeB[i] = (f32x2){cs, sn}; }
            if (wave == 0) {
                const float* d_lq1 = INP(I_LQ1); const float* d_lk1 = INP(I_LK1); const float* d_lq2 = INP(I_LQ2); const float* d_lk2 = INP(I_LK2);
                for (int l = 0; l < 2; ++l) {
                    float a = lane < 32 ? d_lq1[l * 32 + lane] * d_lk1[l * 32 + lane] : 0.f, b = lane < 32 ? d_lq2[l * 32 + lane] * d_lk2[l * 32 + lane] : 0.f;
                    a = wave_sum(a); b = wave_sum(b);
                    const float lam_init = l == 0 ? 0.2f : 0.35550906759096934f;
                    if (lane == 0) lamv[l] = expf(a) - expf(b) + lam_init;
                }
            }
        }
        {
            const float* w_in = INP(I_WIN); const float* w_out = INP(I_WOUT); const float* ffn_w_in = INP(I_FWIN); const float* ffn_w_out = INP(I_FWOUT);
            LAS float* scr = (LAS float*)(lds + wave * 16384);
            constexpr int N_WIN = 16 * 59, N_WOUT = 16 * 32, N_FIN = 16 * 176, N_FOUT = 44 * 32;
            constexpr int NITEMS = 2 * N_WIN + 2 * N_WOUT + N_FIN + 2 * N_FOUT;
            for (int it = gw; it < NITEMS; it += NGW) {
                int r = it;
                if (r < 2 * N_WIN) { const int l = r / N_WIN; transpose_item(w_in + (size_t)l * DM * INW, DM, INW, Win_t + (size_t)l * 2048 * DM, 2, 0, scr, r % N_WIN, lane); continue; } r -= 2 * N_WIN;
                if (r < 2 * N_WOUT) { const int l = r / N_WOUT; transpose_item(w_out + (size_t)l * DM * DM, DM, DM, Wout_t + (size_t)l * DM * DM, 0, 0, scr, r % N_WOUT, lane); continue; } r -= 2 * N_WOUT;
                if (r < N_FOUT) { transpose_item(ffn_w_out, DFF, DM, Fout_t, 0, 0, scr, r, lane); continue; } r -= N_FOUT;
                if (r < N_FIN) { transpose_item<true>(ffn_w_in, DM, 2 * DFF, (void*)(ws + WS_FIN8), 1, DFF, scr, r, lane); continue; } r -= N_FIN;
                transpose_item<true>(ffn_w_out, DFF, DM, (void*)(ws + WS_FOUT8), 0, 0, scr, r, lane);
            }
        }
        for (int i = vcu * 512 + tid; i < 2 * 20480; i += G * 512) { const int l = i / 20480, o = i % 20480; ((u32x4*)(Win_t + (size_t)l * 2048 * DM + (size_t)INW * DM))[o] = (u32x4){0u, 0u, 0u, 0u}; }
        {
            const float* m_wuq = INP(I_WUQ); const float* m_wukv = INP(I_WUKV); const float* m_gcq = INP(I_GCQ); const float* m_gckv = INP(I_GCKV);
            bf16_t* Wukv_t = (bf16_t*)(ws + WS_WUKV);
            for (int i = vcu * 512 + tid; i < 2 * 512 * 256; i += G * 512) { const int l = i / (512 * 256), rem = i % (512 * 256), n = rem / 256, k = rem % 256;
                float vq = 0.f, vkv = 0.f;
                if (n < 384 && k < 192) vq = m_wuq[((size_t)l * 192 + k) * 384 + n] * m_gcq[l * 192 + k];
                if (k >= 64 && k < 192) vkv = m_wukv[((size_t)l * 128 + (k - 64)) * 512 + n] * m_gckv[l * 128 + (k - 64)];
                Wu_t[i] = (bf16_t)(cvtpk(vq, 0.f) & 0xffffu); Wukv_t[i] = (bf16_t)(cvtpk(vkv, 0.f) & 0xffffu); }
        }
    }
    GRID_BAR();

    layer_body<0>(wsbase, args.out, lds, G, vcu, wave);
    layer_body<1>(wsbase, args.out, lds, G, vcu, wave);
}

extern "C" void kernel_launch(void* const* d_in, const int* in_sizes, int n_in, void* d_out, int out_size, void* d_ws, size_t ws_size, hipStream_t stream) {
    static int grid = 0;
    if (grid == 0) {
        if (n_in != 27 || out_size != NTOK * DM || ws_size < WS_END) { fprintf(stderr, "kernel_launch: unexpected sizes (n_in %d, out %d, ws %zu); nothing launched\n", n_in, out_size, ws_size); grid = -1; return; }
        int dev = 0, cus = 0, per_cu = 0;
        if (hipGetDevice(&dev) != hipSuccess || hipDeviceGetAttribute(&cus, hipDeviceAttributeMultiprocessorCount, dev) != hipSuccess) { grid = -1; return; }
        if (hipFuncSetAttribute((const void*)fwd_kernel, hipFuncAttributeMaxDynamicSharedMemorySize, LDS_BYTES) != hipSuccess) { grid = -1; return; }
        if (hipOccupancyMaxActiveBlocksPerMultiprocessor(&per_cu, (const void*)fwd_kernel, NWAVES * 64, LDS_BYTES) != hipSuccess || per_cu < 1)
            fprintf(stderr, "kernel_launch: occupancy query reports %d workgroups per CU\n", per_cu);
        (void)hipGetLastError();
        if (cus < 64) { fprintf(stderr, "kernel_launch: %d CUs (the context side chain needs 32 workgroups beside the others); nothing launched\n", cus); grid = -1; return; }
        grid = cus;
    }
    if (grid < 0) return;
    if (hipMemsetAsync((char*)d_ws + WS_CTL, 0, CTL_ZERO_BYTES, stream) != hipSuccess) return;
    Args a{};
    for (int i = 0; i < 27; ++i) a.in[i] = (const float*)d_in[i];
    a.out = (float*)d_out; a.ws = (unsigned char*)d_ws;
    hipLaunchKernelGGL(fwd_kernel, dim3(grid), dim3(NWAVES * 64), LDS_BYTES, stream, a);
}
```

```cpp
#include <hip/hip_runtime.h>
#include <hip/hip_bf16.h>
#include <cstdio>
#include <cstdint>

#define LAS __attribute__((address_space(3)))
#define GAS __attribute__((address_space(1)))
typedef unsigned short bf16_t;
typedef short bf16x8 __attribute__((ext_vector_type(8)));
typedef short s16x4 __attribute__((ext_vector_type(4)));
typedef float f32x4 __attribute__((ext_vector_type(4)));
typedef float f32x2 __attribute__((ext_vector_type(2)));
typedef float f32x16 __attribute__((ext_vector_type(16)));
typedef unsigned u32x4 __attribute__((ext_vector_type(4)));
typedef unsigned u32x2 __attribute__((ext_vector_type(2)));
typedef __bf16 bf16x2_t __attribute__((ext_vector_type(2)));

constexpr int NB = 8, SEQ = 4096, CTX = 256, TROWS = SEQ + CTX  , MROWS = NB * TROWS  , DM = 1024;
constexpr int TPB = TROWS / 256;
constexpr int NTOK = NB * SEQ;
constexpr int INW = 1888, PW = 1920;
constexpr int DFF = 2816, DFE = 1792, NEXP = 8;
constexpr float NEPS = 1e-6f;
constexpr int PC_GQ = 0, PC_GK = 512, PC_GV = 640, PC_DQ = 768, PC_DK = 1024, PC_DV = 1280, PC_CQ = 1536, PC_CKV = 1728, PC_KR = 1856;
constexpr float SC_G = 0.18033688011112042f;
constexpr float SC_D = 0.25503486164919736f;
constexpr float SC_M = 0.14724444602590306f;

__device__ __forceinline__ unsigned cvtpk(float lo, float hi) { f32x2 v = {lo, hi}; bf16x2_t b = __builtin_convertvector(v, bf16x2_t); return __builtin_bit_cast(unsigned, b); }
__device__ __forceinline__ float bflo(unsigned u) { return __builtin_bit_cast(float, u << 16); }
__device__ __forceinline__ float bfhi(unsigned u) { return __builtin_bit_cast(float, u & 0xffff0000u); }
__device__ __forceinline__ unsigned cvt4_fp8(float a, float b, float c, float d) {
    a = __builtin_amdgcn_fmed3f(a, -448.0f, 448.0f); b = __builtin_amdgcn_fmed3f(b, -448.0f, 448.0f); c = __builtin_amdgcn_fmed3f(c, -448.0f, 448.0f); d = __builtin_amdgcn_fmed3f(d, -448.0f, 448.0f);
    unsigned r = (unsigned)__builtin_amdgcn_cvt_pk_fp8_f32(a, b, 0, false); return (unsigned)__builtin_amdgcn_cvt_pk_fp8_f32(c, d, (int)r, true); }
constexpr float W8_SCALE = 64.0f;
constexpr float W8_INV = 1.0f / 64.0f;
typedef int i32x4 __attribute__((ext_vector_type(4)));
typedef int i32x8 __attribute__((ext_vector_type(8)));

namespace pg8 {
constexpr int BM = 256, BK = 64, HALF = 128, HTB = HALF * BK * 2, STAGE_BYTES = 8 * HTB, NXCD = 8, WGM = 8;
__host__ __device__ __forceinline__ int lds_byte(int r, int c) { const int st = (r >> 4) * 2 + (c >> 5), rr = r & 15, cc = c & 31, ob = rr * 64 + cc * 2; return st * 1024 + (ob ^ (((ob >> 9) & 1) << 5)); }
__host__ __device__ __forceinline__ void stage_rc(int b, int& R, int& C) { const int st = b / 1024, sb = b % 1024, swz = sb ^ (((sb >> 9) & 1) << 5); R = (st >> 1) * 16 + swz / 64; C = (st & 1) * 32 + (swz % 64) / 2; }
__host__ __device__ __forceinline__ int perm32(int rho) { const int n = rho >> 4, i = rho & 15; return 8 * (i >> 2) + 4 * n + (i & 3); }
struct Unit { int pm, pn; int hh = 0; };
struct Gemm { const bf16_t* A; const bf16_t* Bt; int lda; int K; };
struct StaticOrder {
    int nM, nN, nwg, G, c;
    __device__ void init(int nM_, int nN_, int G_, int c_) { nM = nM_; nN = nN_; nwg = nM * nN; G = G_; c = c_; }
    __device__ bool next(int i, Unit& u) const {
        const long L = (long)i * G + c; if (L >= nwg) return false;
        int wgid = (int)L; { const int q = nwg / NXCD, r = nwg % NXCD, xcd = wgid % NXCD, off = wgid / NXCD; wgid = (xcd < r ? xcd * (q + 1) : r * (q + 1) + (xcd - r) * q) + off; }
        const int nig = WGM * nN, gid = wgid / nig, fm = gid * WGM, gsz = (nM - fm) < WGM ? (nM - fm) : WGM;
        u.pm = fm + ((wgid % nig) % gsz); u.pn = (wgid % nig) / gsz; return true;
    }
    __device__ void decode_plain(int wgid, Unit& u) const { const int nig = WGM * nN, gid = wgid / nig, fm = gid * WGM, gsz = (nM - fm) < WGM ? (nM - fm) : WGM; u.pm = fm + ((wgid % nig) % gsz); u.pn = (wgid % nig) / gsz; }
};
template <int MODE> struct MapOrder {
    StaticOrder so; int t0, nct; const int* tile_e;
    __device__ bool next(int i, Unit& u) const {
        if (!so.next(i, u)) return false;
        if (MODE == 1) { u.pm = u.pm + u.pm / 16 + 1; }
        if (MODE == 2) { const int e = tile_e[t0 + u.pm]; u.pm = t0 + u.pm; u.pn = e * nct + u.pn; }
        if (MODE == 3) { const int e = tile_e[t0 + u.pm]; u.pn = e * nct + u.pn; }
        return true;
    }
};
struct MoeTailOrder {
    StaticOrder so; int nfull, ntot, c, nct; const int* tile_e;
    __device__ bool next(int i, Unit& u) const { const int j = c; if (i > 0 || nfull + j / 2 >= ntot) return false; so.decode_plain(nfull + j / 2, u); u.hh = j & 1; const int e = tile_e[u.pm]; u.pn = e * nct + u.pn; return true; }
};
struct TailOrder {
    int nU, stride, k, pn; bool on;
    __device__ void init(int nU_, int pn_, int G_, int c_, int nfull) { nU = nU_; pn = pn_; const int r = nfull % G_, idle = r ? G_ - r : 0;
        if (idle > 0 && idle * 2 >= nU_) { on = c_ >= r; stride = idle; k = c_ - r; } else { on = true; stride = G_; k = c_; } }
    __device__ bool next(int i, Unit& u) const { const int L = k + i * stride; if (!on || L >= nU) return false; u.pm = L; u.pn = pn; return true; }
};
struct RotOrder {
    int nM, nN, pn0, G, k;
    __device__ void init(int nM_, int nN_, int pn0_, int G_, int c_, int rot) { nM = nM_; nN = nN_; pn0 = pn0_; G = G_; k = ((c_ - rot) % G_ + G_) % G_; }
    __device__ bool next(int i, Unit& u) const { const int L = k + i * G; if (L >= nM * nN) return false; u.pm = L / nN; u.pn = pn0 + L % nN; return true; }
};
struct CtxOrder {
    int c, mul;
    __device__ bool next(int i, Unit& u) const { if (i > 0 || c >= 32) return false; u.pm = (c & 7) * mul; u.pn = c >> 3; return true; }
};
template <class Epi, class Sched, bool ALIGN_EPI, int ESZ = 2, bool HN = false>
__device__ __forceinline__ void gemm_phase(LAS unsigned char* lds, const Gemm g, const Sched& S, const Epi& E) {
    int tid_ = threadIdx.x; asm volatile("" : "+v"(tid_));
    const int tid = tid_, wid = __builtin_amdgcn_readfirstlane(tid >> 6), lane = tid & 63, wr = wid >> 2, wc = wid & 3, fr = lane & 15, fq = lane >> 4;
    const int K = g.K, nt = K * ESZ / (BK * 2), lda = g.lda;
    unsigned voffA[2], voffB[2];
#pragma unroll
    for (int i = 0; i < 2; ++i) { int R, C; stage_rc(tid * 16 + i * 8192, R, C); const int Rb = Epi::PERM ? ((R & ~31) + perm32(R & 31)) : R;
        voffA[i] = (unsigned)(R * lda * ESZ + C * 2); voffB[i] = (unsigned)(Rb * K * ESZ + C * 2); }
    const size_t kstep = (size_t)(BK * 2);
    const size_t hstepA = (size_t)HALF * lda * ESZ, hstepB = (size_t)HALF * K * ESZ;
    const size_t tstepA = 2 * hstepA, tstepB = 2 * hstepB;
    const unsigned ldsw = (unsigned)wid * 1024u;
    const int aoff = lds_byte(wr * 64 + fr, fq * 8), boff = lds_byte(wc * 32 + fr, fq * 8);
#define PG8_SA(b, h) (((b) * 2 + (h)) * HTB)
#define PG8_SB(b, h) ((4 + (b) * 2 + (h)) * HTB)
#define PG8_STAGE(bufoff, gbase, voff) do { _Pragma("unroll") for (int _i = 0; _i < 2; ++_i) \
        __builtin_amdgcn_global_load_lds((const unsigned*)((const char*)(gbase) + (voff)[_i]), (LAS unsigned*)(lds + (bufoff) + ldsw + _i * 8192), 16, 0, 0); } while (0)
#define PG8_LD8(p_) __builtin_shufflevector(*(const LAS i32x4*)(p_), *(const LAS i32x4*)((p_) + 1024), 0, 1, 2, 3, 4, 5, 6, 7)
#define PG8_LDA(dst, b, h) do { if constexpr (ESZ == 2) { _Pragma("unroll") for (int m = 0; m < 4; ++m) _Pragma("unroll") for (int k = 0; k < 2; ++k) dst[m][k] = *(const LAS bf16x8*)(lds + PG8_SA(b, h) + aoff + m * 2048 + k * 1024); } \
        else { _Pragma("unroll") for (int m = 0; m < 4; ++m) dst##8[m] = PG8_LD8(lds + PG8_SA(b, h) + aoff + m * 2048); } } while (0)
#define PG8_LDB(dst, b, h) do { if constexpr (ESZ == 2) { _Pragma("unroll") for (int n = 0; n < 2; ++n) _Pragma("unroll") for (int k = 0; k < 2; ++k) dst[n][k] = *(const LAS bf16x8*)(lds + PG8_SB(b, h) + boff + n * 2048 + k * 1024); } \
        else { _Pragma("unroll") for (int n = 0; n < 2; ++n) dst##8[n] = PG8_LD8(lds + PG8_SB(b, h) + boff + n * 2048); } } while (0)
#define PG8_CAT(x0, x1) __builtin_shufflevector(__builtin_bit_cast(i32x4, x0), __builtin_bit_cast(i32x4, x1), 0, 1, 2, 3, 4, 5, 6, 7)
#define PG8_MMA(ai, bj, At, Bt) do { __builtin_amdgcn_s_setprio(1); _Pragma("unroll") for (int m = 0; m < 4; ++m) _Pragma("unroll") for (int n = 0; n < 2; ++n) { \
        if constexpr (ESZ == 2) { _Pragma("unroll") for (int k = 0; k < 2; ++k) acc[ai][bj][m][n] = __builtin_amdgcn_mfma_f32_16x16x32_bf16(Bt[n][k], At[m][k], acc[ai][bj][m][n], 0, 0, 0); } \
        else { asm volatile("v_mfma_f32_16x16x128_f8f6f4 %0, %1, %2, %0" : "+v"(acc[ai][bj][m][n]) : "v"(Bt##8[n]), "v"(At##8[m])); } } \
        __builtin_amdgcn_s_setprio(0); } while (0)
#define PG8_WAIT_V(n) asm volatile("s_waitcnt vmcnt(" #n ")" ::: "memory")
#define PG8_WAIT_L(n) asm volatile("s_waitcnt lgkmcnt(" #n ")" ::: "memory")
#define PG8_BAR __builtin_amdgcn_s_barrier()
#define PG8_SCHED __builtin_amdgcn_sched_barrier(0)
    Unit cur, nxt; int ui = 0;
    if (!S.next(0, cur)) return;
    f32x4 acc[2][2][4][2];
#pragma unroll
    for (int a = 0; a < 2; ++a)
#pragma unroll
        for (int b = 0; b < 2; ++b)
#pragma unroll
            for (int m = 0; m < 4; ++m)
#pragma unroll
                for (int n = 0; n < 2; ++n) acc[a][b][m][n] = (f32x4){0.f, 0.f, 0.f, 0.f};
    bf16x8 At[4][2], B0[2][2], B1[2][2]; i32x8 At8[4], B08[2], B18[2];
    const char* cA = (const char*)g.A + (size_t)cur.pm * tstepA; const char* cB = (const char*)g.Bt + (size_t)cur.pn * tstepB + (size_t)cur.hh * hstepB;
    PG8_STAGE(PG8_SB(0, 0), cB, voffB); PG8_STAGE(PG8_SB(0, 1), cB + hstepB, voffB); PG8_STAGE(PG8_SA(0, 0), cA, voffA); PG8_STAGE(PG8_SA(0, 1), cA + hstepA, voffA);
    if (wr == 1) PG8_BAR;
    PG8_WAIT_V(2); PG8_BAR;
    PG8_STAGE(PG8_SB(1, 0), cB + kstep, voffB); PG8_STAGE(PG8_SA(1, 0), cA + kstep, voffA); PG8_STAGE(PG8_SB(1, 1), cB + hstepB + kstep, voffB);
    PG8_WAIT_V(6); PG8_BAR;
    for (;;) {
        const bool has_next = S.next(ui + 1, nxt);
        const char* nA = has_next ? (const char*)g.A + (size_t)nxt.pm * tstepA : cA; const char* nB = has_next ? (const char*)g.Bt + (size_t)nxt.pn * tstepB + (size_t)nxt.hh * hstepB : cB;
#pragma nounroll
        for (int t = 0; t < nt; t += 2) {
            const bool last = (t == nt - 2);
            const char* a1 = cA + (size_t)(t + 1) * kstep;
            const char* a2 = last ? nA : cA + (size_t)(t + 2) * kstep; const char* b2 = last ? nB : cB + (size_t)(t + 2) * kstep;
            const char* a3 = a2 + kstep; const char* b3 = b2 + kstep;
            PG8_LDB(B0, 0, 0); if constexpr (!HN) PG8_LDB(B1, 0, 1); PG8_SCHED; PG8_LDA(At, 0, 0); PG8_STAGE(PG8_SA(1, 1), a1 + hstepA, voffA);
            PG8_WAIT_V(8); PG8_WAIT_L(0); PG8_BAR; PG8_MMA(0, 0, At, B0); if constexpr (!HN) PG8_MMA(0, 1, At, B1); PG8_BAR; PG8_SCHED;
            PG8_LDA(At, 0, 1); PG8_STAGE(PG8_SB(0, 0), b2, voffB); PG8_STAGE(PG8_SB(0, 1), b2 + hstepB, voffB); PG8_STAGE(PG8_SA(0, 0), a2, voffA);
            PG8_WAIT_V(8); PG8_WAIT_L(0); PG8_BAR; PG8_MMA(1, 0, At, B0); if constexpr (!HN) PG8_MMA(1, 1, At, B1); PG8_BAR; PG8_SCHED;
            PG8_LDB(B0, 1, 0); if constexpr (!HN) PG8_LDB(B1, 1, 1); PG8_SCHED; PG8_LDA(At, 1, 0); PG8_STAGE(PG8_SA(0, 1), a2 + hstepA, voffA);
            PG8_WAIT_V(8); PG8_WAIT_L(0); PG8_BAR; PG8_MMA(0, 0, At, B0); if constexpr (!HN) PG8_MMA(0, 1, At, B1); PG8_BAR; PG8_SCHED;
            PG8_LDA(At, 1, 1); PG8_STAGE(PG8_SB(1, 0), b3, voffB); PG8_STAGE(PG8_SB(1, 1), b3 + hstepB, voffB); PG8_STAGE(PG8_SA(1, 0), a3, voffA);
            PG8_WAIT_V(8); PG8_WAIT_L(0); PG8_BAR; PG8_MMA(1, 0, At, B0); if constexpr (!HN) PG8_MMA(1, 1, At, B1); PG8_BAR; PG8_SCHED;
        }
        if constexpr (ALIGN_EPI) { if (wr == 0) PG8_BAR; }
        if constexpr (ESZ == 1) {
            asm volatile("s_nop 15\n\ts_nop 7" : "+v"(acc[1][1][0][0]), "+v"(acc[1][1][0][1]), "+v"(acc[1][1][1][0]), "+v"(acc[1][1][1][1]), "+v"(acc[1][1][2][0]), "+v"(acc[1][1][2][1]), "+v"(acc[1][1][3][0]), "+v"(acc[1][1][3][1])); }
        { int t2 = threadIdx.x; asm volatile("" : "+v"(t2)); const int l2 = t2 & 63; E(acc, cur, wr, wc, l2 & 15, l2 >> 4); }
        if (!has_next) break;
#pragma unroll
        for (int a = 0; a < 2; ++a)
#pragma unroll
            for (int b = 0; b < 2; ++b)
#pragma unroll
                for (int m = 0; m < 4; ++m)
#pragma unroll
                    for (int n = 0; n < 2; ++n) acc[a][b][m][n] = (f32x4){0.f, 0.f, 0.f, 0.f};
        cur = nxt; cA = nA; cB = nB; ++ui;
        if constexpr (ALIGN_EPI) { if (wr == 1) PG8_BAR; }
    }
    PG8_WAIT_V(0);
    if constexpr (!ALIGN_EPI) { if (wr == 0) PG8_BAR; }
    PG8_BAR;
#undef PG8_SA
#undef PG8_SB
#undef PG8_STAGE
#undef PG8_LDA
#undef PG8_LD8
#undef PG8_LDB
#undef PG8_MMA
#undef PG8_CAT
#undef PG8_WAIT_V
#undef PG8_WAIT_L
#undef PG8_BAR
#undef PG8_SCHED
}

__device__ __forceinline__ u32x4 pack8(const f32x4 a, const f32x4 b) { u32x4 w; w.x = cvtpk(a[0], a[1]); w.y = cvtpk(a[2], a[3]); w.z = cvtpk(b[0], b[1]); w.w = cvtpk(b[2], b[3]); return w; }
struct EpiBf16 {
    static constexpr bool PERM = true;
    bf16_t* O; int ldc, ncols, nct, row_add; float accscale;
    __device__ __forceinline__ void operator()(const f32x4 (&acc)[2][2][4][2], const Unit& u, int wr, int wc, int fr, int fq) const {
        const int row0 = (u.pm + row_add) * BM + wr * 64 + fr; const int colt = (u.pn % nct) * BM + wc * 32 + 8 * fq;
#pragma unroll
        for (int bj = 0; bj < 2; ++bj) { const int col0 = colt + bj * HALF; if (col0 < ncols) {
#pragma unroll
            for (int ai = 0; ai < 2; ++ai)
#pragma unroll
                for (int m = 0; m < 4; ++m) __builtin_nontemporal_store(pack8(acc[ai][bj][m][0] * accscale, acc[ai][bj][m][1] * accscale), (u32x4*)(O + (size_t)(row0 + ai * HALF + m * 16) * ldc + col0)); } }
    }
};
struct EpiBf16H {
    static constexpr bool PERM = true;
    bf16_t* O; int ldc, nct, row_add; float accscale;
    __device__ __forceinline__ void operator()(const f32x4 (&acc)[2][2][4][2], const Unit& u, int wr, int wc, int fr, int fq) const {
        const int row0 = (u.pm + row_add) * BM + wr * 64 + fr; const int col0 = (u.pn % nct) * BM + u.hh * HALF + wc * 32 + 8 * fq;
#pragma unroll
        for (int ai = 0; ai < 2; ++ai)
#pragma unroll
            for (int m = 0; m < 4; ++m) __builtin_nontemporal_store(pack8(acc[ai][0][m][0] * accscale, acc[ai][0][m][1] * accscale), (u32x4*)(O + (size_t)(row0 + ai * HALF + m * 16) * ldc + col0));
    }
};
template <bool OUT8, bool IN8 = OUT8> struct EpiSwiglu {
    static constexpr bool PERM = true;
    void* O; int ldc, nct, row_sub;
    __device__ __forceinline__ void operator()(const f32x4 (&acc)[2][2][4][2], const Unit& u, int wr, int wc, int fr, int fq) const {
        const int row0 = (u.pm - row_sub) * BM + wr * 64 + fr; const int col0 = (u.pn % nct) * HALF + wc * 32 + 8 * fq;
#pragma unroll
        for (int ai = 0; ai < 2; ++ai)
#pragma unroll
            for (int m = 0; m < 4; ++m) { f32x4 r[2];
#pragma unroll
                for (int n = 0; n < 2; ++n) { const f32x4 gt = acc[ai][0][m][n], up = acc[ai][1][m][n];
                    constexpr float ES = IN8 ? -1.4426950408889634f * W8_INV : -1.4426950408889634f, DS = IN8 ? 4096.0f : 1.0f;
                    const f32x4 gu = gt * up;
#pragma unroll
                    for (int j = 0; j < 4; ++j) { const float e = __builtin_amdgcn_exp2f(gt[j] * ES); r[n][j] = gu[j] * __builtin_amdgcn_rcpf(__builtin_fmaf(e, DS, DS)); } }
                const size_t off = (size_t)(row0 + ai * HALF + m * 16) * ldc + col0;
                if constexpr (OUT8) { u32x2 w; w.x = cvt4_fp8(r[0][0], r[0][1], r[0][2], r[0][3]); w.y = cvt4_fp8(r[1][0], r[1][1], r[1][2], r[1][3]); *(u32x2*)((unsigned char*)O + off) = w; }
                else *(u32x4*)((bf16_t*)O + off) = pack8(r[0], r[1]); }
    }
};
template <bool UNI> struct EpiRes {
    static constexpr bool PERM = true;
    const float* xin; const float* cin; bf16_t* xw; const float* modl; int which; float accscale; int pm_mul;
    __device__ __forceinline__ void operator()(const f32x4 (&acc)[2][2][4][2], const Unit& u, int wr, int wc, int fr, int fq) const {
        const int pme = u.pm * pm_mul; const int b = pme / TPB, jt = pme % TPB;
        bf16_t* out = xw + (size_t)pme * BM * DM;
        const float* basef = (jt == 0 ? cin + (size_t)b * CTX * DM : xin + ((size_t)b * SEQ + (size_t)(jt - 1) * BM) * DM);
        const float* gate = modl + (size_t)((jt == 0 ? 8 : b) * 6 + which) * DM;
        const int col0 = u.pn * BM + wc * 32 + 8 * fq;
        f32x4 gv[2][2];
#pragma unroll
        for (int bj = 0; bj < 2; ++bj)
#pragma unroll
            for (int n = 0; n < 2; ++n) gv[bj][n] = *(const f32x4*)(gate + col0 + bj * HALF + 4 * n) * accscale;
#pragma unroll
        for (int ai = 0; ai < 2; ++ai) {
            if constexpr (UNI) { u32x4 bs[4][2];
#pragma unroll
                for (int m = 0; m < 4; ++m)
#pragma unroll
                    for (int bj = 0; bj < 2; ++bj) bs[m][bj] = __builtin_nontemporal_load((const u32x4*)(out + (size_t)(ai * HALF + wr * 64 + m * 16 + fr) * DM + col0 + bj * HALF));
#pragma unroll
                for (int m = 0; m < 4; ++m)
#pragma unroll
                    for (int bj = 0; bj < 2; ++bj) { const u32x4 w = bs[m][bj];
                        const f32x4 b0 = (f32x4){bflo(w.x), bfhi(w.x), bflo(w.y), bfhi(w.y)}, b1 = (f32x4){bflo(w.z), bfhi(w.z), bflo(w.w), bfhi(w.w)};
                        *(u32x4*)(out + (size_t)(ai * HALF + wr * 64 + m * 16 + fr) * DM + col0 + bj * HALF) = pack8(b0 + gv[bj][0] * acc[ai][bj][m][0], b1 + gv[bj][1] * acc[ai][bj][m][1]); }
            } else { f32x4 bs[4][2][2];
#pragma unroll
                for (int m = 0; m < 4; ++m)
#pragma unroll
                    for (int bj = 0; bj < 2; ++bj)
#pragma unroll
                        for (int n = 0; n < 2; ++n) bs[m][bj][n] = __builtin_nontemporal_load((const f32x4*)(basef + (size_t)(ai * HALF + wr * 64 + m * 16 + fr) * DM + col0 + bj * HALF + 4 * n));
#pragma unroll
                for (int m = 0; m < 4; ++m)
#pragma unroll
                    for (int bj = 0; bj < 2; ++bj)
                        *(u32x4*)(out + (size_t)(ai * HALF + wr * 64 + m * 16 + fr) * DM + col0 + bj * HALF) = pack8(bs[m][bj][0] + gv[bj][0] * acc[ai][bj][m][0], bs[m][bj][1] + gv[bj][1] * acc[ai][bj][m][1]);
            }
        }
    }
};
struct EpiMla {
    static constexpr bool PERM = true;
    bf16_t* QM; bf16_t* KN; bf16_t* VM; const float* MS; LAS float* bslot; int cbase, cend;
    __device__ __forceinline__ void operator()(const f32x4 (&acc)[2][2][4][2], const Unit& u, int wr, int wc, int fr, int fq) const {
        const int row0 = u.pm * BM + wr * 64 + fr;
#pragma unroll
        for (int bj = 0; bj < 2; ++bj) { const int cb = cbase + u.pn * BM + bj * HALF + wc * 32;
            if (cb < cend) { bf16_t* dst; int ld; float sc; int which = -1;
                if (cb < 384) { dst = QM + cb; ld = 384; sc = SC_M; which = 0; }
                else { const int cc = cb - 384, hd = cc >> 7, d = cc & 127; dst = (d < 64 ? KN + hd * 64 + d : VM + hd * 64 + (d - 64)); ld = 256; sc = 1.0f; if (d < 64) which = 1; }
                float rmax = 0.f;
                float rs[2][4];
#pragma unroll
                for (int ai = 0; ai < 2; ++ai)
#pragma unroll
                    for (int m = 0; m < 4; ++m) { const float* ms = MS + (size_t)(row0 + ai * HALF + m * 16) * 16;
                        if (cb < 384) { const f32x4 s4 = *(const f32x4*)ms; const f32x2 s2 = *(const f32x2*)(ms + 4); rs[ai][m] = ((s4[0] + s4[1]) + (s4[2] + s4[3])) + (s2[0] + s2[1]); }
                        else { const f32x4 s4 = *(const f32x4*)(ms + 8); rs[ai][m] = (s4[0] + s4[1]) + (s4[2] + s4[3]); } }
#pragma unroll
                for (int ai = 0; ai < 2; ++ai)
#pragma unroll
                    for (int m = 0; m < 4; ++m) { const int row = row0 + ai * HALF + m * 16; const float scr_ = sc * __builtin_amdgcn_rsqf(rs[ai][m] * (cb < 384 ? 1.f / 192.f : 1.f / 128.f) + NEPS);
                        const f32x4 a = acc[ai][bj][m][0] * scr_, c = acc[ai][bj][m][1] * scr_;
                        *(u32x4*)(dst + (size_t)row * ld + 8 * fq) = pack8(a, c);
                        float sq = ((a[0] * a[0] + a[1] * a[1]) + (a[2] * a[2] + a[3] * a[3])) + ((c[0] * c[0] + c[1] * c[1]) + (c[2] * c[2] + c[3] * c[3]));
                        sq += __builtin_bit_cast(float, __builtin_amdgcn_ds_swizzle(__builtin_bit_cast(int, sq), (16 << 10) | 0x1f));
                        { auto rr = __builtin_amdgcn_permlane32_swap(__float_as_uint(sq), __float_as_uint(sq), false, false); sq = __uint_as_float(rr[0]) + __uint_as_float(rr[1]); }
                        rmax = fmaxf(rmax, sq); }
                if (which >= 0) {
                    rmax = fmaxf(rmax, __builtin_bit_cast(float, __builtin_amdgcn_ds_swizzle(__builtin_bit_cast(int, rmax), (1 << 10) | 0x1f))); rmax = fmaxf(rmax, __builtin_bit_cast(float, __builtin_amdgcn_ds_swizzle(__builtin_bit_cast(int, rmax), (2 << 10) | 0x1f)));
                    rmax = fmaxf(rmax, __builtin_bit_cast(float, __builtin_amdgcn_ds_swizzle(__builtin_bit_cast(int, rmax), (4 << 10) | 0x1f))); rmax = fmaxf(rmax, __builtin_bit_cast(float, __builtin_amdgcn_ds_swizzle(__builtin_bit_cast(int, rmax), (8 << 10) | 0x1f)));
                    if (fr == 0 && fq == 0) { LAS float* p = bslot + (wr * 4 + wc) * 2 + which; *p = fmaxf(*p, rmax); } }
            }
        }
    }
};
__device__ __forceinline__ float quad_sum(float s) {
    s += __builtin_bit_cast(float, __builtin_amdgcn_ds_swizzle(__builtin_bit_cast(int, s), (16 << 10) | 0x1f));
    auto rr = __builtin_amdgcn_permlane32_swap(__float_as_uint(s), __float_as_uint(s), false, false); return __uint_as_float(rr[0]) + __uint_as_float(rr[1]); }
__device__ __forceinline__ float dot4(const f32x4 a) { return (a[0] * a[0] + a[1] * a[1]) + (a[2] * a[2] + a[3] * a[3]); }
__device__ __forceinline__ void rot8(f32x4& a, f32x4& c, const f32x4 t0, const f32x4 t1) {
    const f32x4 a_ = a, c_ = c;
    a[0] = a_[0] * t0[0] - a_[1] * t0[1]; a[1] = a_[0] * t0[1] + a_[1] * t0[0]; a[2] = a_[2] * t0[2] - a_[3] * t0[3]; a[3] = a_[2] * t0[3] + a_[3] * t0[2];
    c[0] = c_[0] * t1[0] - c_[1] * t1[1]; c[1] = c_[0] * t1[1] + c_[1] * t1[0]; c[2] = c_[2] * t1[2] - c_[3] * t1[3]; c[3] = c_[2] * t1[3] + c_[3] * t1[2]; }
struct EpiIn {
    static constexpr bool PERM = true;
    bf16_t* P; float* MS; const f32x2* ropeA; const f32x2* ropeB; const float* gq; const float* gk; LAS float* bslot; bf16_t* KTG;
    __device__ __forceinline__ void plain(const f32x4 (&acc)[2][2][4][2], int bj, bf16_t* dst) const {
#pragma unroll
        for (int ai = 0; ai < 2; ++ai)
#pragma unroll
            for (int m = 0; m < 4; ++m) *(u32x4*)(dst + (size_t)(ai * HALF + m * 16) * PW) = pack8(acc[ai][bj][m][0], acc[ai][bj][m][1]);
    }
    __device__ __forceinline__ void head64(const f32x4 (&acc)[2][2][4][2], bf16_t* dst, const float* g, float sc, int jt, int wr, int fr, int fq, bf16_t* KT = nullptr) const {
        f32x4 gs[2][2];
#pragma unroll
        for (int bj = 0; bj < 2; ++bj)
#pragma unroll
            for (int n = 0; n < 2; ++n) gs[bj][n] = *(const f32x4*)(g + 32 * bj + 8 * fq + 4 * n) * sc;
        f32x4 cA[2][2];
        if (jt != 0) {
#pragma unroll
            for (int ai = 0; ai < 2; ++ai) { const f32x4* t = (const f32x4*)(ropeA + ((jt - 1) * 4 + ai * 2 + wr) * 16 + 4 * fq); cA[ai][0] = t[0]; cA[ai][1] = t[1]; } }
#pragma unroll
        for (int m = 0; m < 4; ++m) { f32x4 cB0, cB1;
            if (jt != 0) { const f32x4* t = (const f32x4*)(ropeA + (m * 16 + fr) * 16 + 4 * fq); cB0 = t[0]; cB1 = t[1]; }
#pragma unroll
            for (int ai = 0; ai < 2; ++ai) { f32x4 a0 = acc[ai][0][m][0], a1 = acc[ai][0][m][1], b0 = acc[ai][1][m][0], b1 = acc[ai][1][m][1];
                const float ss = quad_sum((dot4(a0) + dot4(a1)) + (dot4(b0) + dot4(b1)));
                const float rstd = __builtin_amdgcn_rsqf(ss * (1.f / 64.f) + NEPS);
                a0 = a0 * rstd * gs[0][0]; a1 = a1 * rstd * gs[0][1]; b0 = b0 * rstd * gs[1][0]; b1 = b1 * rstd * gs[1][1];
                if (jt != 0) { rot8(a0, a1, cA[ai][0], cA[ai][1]); rot8(b0, b1, cB0, cB1); }
                if (KT != nullptr) { bf16_t* o = KT + (size_t)(ai * 2) * 4096 + fq * 512 + (m * 16) * 8; *(u32x4*)o = pack8(a0, a1); *(u32x4*)(o + 4 * 512) = pack8(b0, b1); }
                else { bf16_t* o = dst + (size_t)(ai * HALF + m * 16) * PW; *(u32x4*)o = pack8(a0, a1); *(u32x4*)(o + HALF) = pack8(b0, b1); } } }
    }
    template <int MODE> __device__ __forceinline__ void blk32(const f32x4 (&acc)[2][2][4][2], int bj, bf16_t* dst, float sc, int tslot, int mslot, size_t row0, int jt, int wr, int wc, int fr, int fq) const {
        float rmax = 0.f;
#pragma unroll
        for (int ai = 0; ai < 2; ++ai)
#pragma unroll
            for (int m = 0; m < 4; ++m) { f32x4 a = acc[ai][bj][m][0], c = acc[ai][bj][m][1];
                if constexpr ((MODE & 6) != 0) { const float ss = quad_sum(dot4(a) + dot4(c));
                    if constexpr ((MODE & 2) != 0) rmax = fmaxf(rmax, ss);
                    if constexpr ((MODE & 4) != 0) { if (fq == 0) MS[(row0 + ai * HALF + m * 16) * 16 + mslot] = ss; } }
                if constexpr ((MODE & 1) != 0) { if (jt != 0) { const int pos = fq < 2 ? (jt - 1) * 4 + ai * 2 + wr : m * 16 + fr; const f32x4* t = (const f32x4*)(ropeB + pos * 8 + ((4 * fq) & 7)); rot8(a, c, t[0], t[1]); } }
                *(u32x4*)(dst + (size_t)(ai * HALF + m * 16) * PW) = pack8(a * sc, c * sc); }
        if constexpr ((MODE & 2) != 0) { rmax *= sc * sc;
            rmax = fmaxf(rmax, __builtin_bit_cast(float, __builtin_amdgcn_ds_swizzle(__builtin_bit_cast(int, rmax), (1 << 10) | 0x1f))); rmax = fmaxf(rmax, __builtin_bit_cast(float, __builtin_amdgcn_ds_swizzle(__builtin_bit_cast(int, rmax), (2 << 10) | 0x1f)));
            rmax = fmaxf(rmax, __builtin_bit_cast(float, __builtin_amdgcn_ds_swizzle(__builtin_bit_cast(int, rmax), (4 << 10) | 0x1f))); rmax = fmaxf(rmax, __builtin_bit_cast(float, __builtin_amdgcn_ds_swizzle(__builtin_bit_cast(int, rmax), (8 << 10) | 0x1f)));
            if (fr == 0 && fq == 0) { LAS float* p = bslot + (wr * 4 + wc) * 4 + tslot; *p = fmaxf(*p, rmax); } }
    }
    __device__ __forceinline__ void operator()(const f32x4 (&acc)[2][2][4][2], const Unit& u, int wr, int wc, int fr, int fq) const {
        const int jt = u.pm % TPB, pn = u.pn;
        const size_t row0 = (size_t)u.pm * BM + wr * 64 + fr;
        bf16_t* dst = P + row0 * PW + pn * BM + wc * 32 + 8 * fq;
        if (pn < 2) head64(acc, dst, gq, SC_G, jt, wr, fr, fq);
        else if (pn == 2) { if (wc < 2) head64(acc, dst, gk, 1.0f, jt, wr, fr, fq, KTG + ((size_t)wc * (MROWS / 64) + (size_t)u.pm * 4 + wr) * 4096 + fr * 8); else { plain(acc, 0, dst); plain(acc, 1, dst + HALF); } }
        else if (pn == 3) { blk32<3>(acc, 0, dst, SC_D, 0, 0, row0, jt, wr, wc, fr, fq); blk32<3>(acc, 1, dst + HALF, SC_D, 0, 0, row0, jt, wr, wc, fr, fq); }
        else if (pn == 4) { blk32<3>(acc, 0, dst, 1.0f, 1, 0, row0, jt, wr, wc, fr, fq); blk32<3>(acc, 1, dst + HALF, 1.0f, 1, 0, row0, jt, wr, wc, fr, fq); }
        else if (pn == 5) { plain(acc, 0, dst); plain(acc, 1, dst + HALF); }
        else if (pn == 6) { blk32<4>(acc, 0, dst, 1.0f, 0, wc, row0, jt, wr, wc, fr, fq); blk32<4>(acc, 1, dst + HALF, 1.0f, 0, wc < 2 ? 4 + wc : 6 + wc, row0, jt, wr, wc, fr, fq); }
        else { if (wc < 2) blk32<4>(acc, 0, dst, 1.0f, 0, 10 + wc, row0, jt, wr, wc, fr, fq); else if (wc == 2) blk32<3>(acc, 0, dst, 1.0f, 2, 0, row0, jt, wr, wc, fr, fq); else plain(acc, 0, dst); }
    }
};
}

#ifndef ATTN_STORE16
#define ATTN_STORE16(p,v) (*(u32x4*)(p)=(v))
#endif
namespace attn_body {
using bf16=__hip_bfloat16;
using bf16x8=__attribute__((ext_vector_type(8)))short;
using s16x4=__attribute__((ext_vector_type(4)))short;
using f32x16=__attribute__((ext_vector_type(16)))float;
using u32x4=__attribute__((ext_vector_type(4)))unsigned;
constexpr int D=64;
constexpr int NW=8,QBLK=32,QB=QBLK*NW,KVBLK=64;
__device__ __forceinline__ int crow(int r,int hi){return (r&3)+8*(r>>2)+4*hi;}
#define SBAR() __builtin_amdgcn_sched_barrier(0)
constexpr int NSLOT=3, SLOTB=8192;
constexpr int LDS_K=0, LDS_V=NSLOT*SLOTB, LDS_WS=2*NSLOT*SLOTB, LDS_OST=LDS_WS+NW*64*4, LDS_STASH=LDS_OST+NW*4096, LDS_BYTES=LDS_STASH+NW*4096;
constexpr float C2=0.125f*1.4426950408889634f;
__device__ __forceinline__ void glds16(const void*gsrc,unsigned lds_dst){unsigned keep;
  asm volatile("s_mov_b32 %0, m0\n\ts_mov_b32 m0, %2\n\ts_nop 0\n\tglobal_load_lds_dwordx4 %1, off\n\ts_mov_b32 m0, %0":"=&s"(keep):"v"(gsrc),"s"(lds_dst):"memory");}
__device__ __forceinline__ float max3f(float a,float b,float c){float r;asm("v_max3_f32 %0, %1, %2, %3":"=v"(r):"v"(a),"v"(b),"v"(c));return r;}
__device__ __forceinline__ float max2f(float a,float b){float r;asm("v_max_f32_e32 %0, %1, %2":"=v"(r):"v"(a),"v"(b));return r;}
__device__ __forceinline__ float fadd_s(float a,float b){float r;asm("v_add_f32_e32 %0, %1, %2":"=v"(r):"v"(a),"v"(b));return r;}
__device__ __forceinline__ float fsub_s(float a,float b){float r;asm("v_sub_f32_e32 %0, %1, %2":"=v"(r):"v"(a),"v"(b));return r;}
typedef float f32x2_t __attribute__((ext_vector_type(2))); typedef __bf16 bf16x2_t __attribute__((ext_vector_type(2)));
__device__ __forceinline__ unsigned cvtpk_s(float lo,float hi){f32x2_t v={lo,hi};bf16x2_t b=__builtin_convertvector(v,bf16x2_t);return __builtin_bit_cast(unsigned,b);}
#define WAIT_BAR(N) asm volatile("s_waitcnt vmcnt(" #N ") lgkmcnt(0)\n\ts_barrier":::"memory")

template<int NS_> __device__ __forceinline__ void qkt(f32x16&p0,f32x16&p1,const char*Kslot,const bf16x8*qr,const f32x16&negm,int r32,int hi){
  const char*kb=Kslot+hi*1024+r32*16;
  #pragma unroll
  for(int d0=0;d0<NS_;++d0){
    const bf16x8 b0=*reinterpret_cast<const bf16x8*>(kb+d0*2048);
    const bf16x8 b1=*reinterpret_cast<const bf16x8*>(kb+d0*2048+512);
    if(d0==0){p0=__builtin_amdgcn_mfma_f32_32x32x16_bf16(b0,qr[0],negm,0,0,0);p1=__builtin_amdgcn_mfma_f32_32x32x16_bf16(b1,qr[0],negm,0,0,0);}
    else{p0=__builtin_amdgcn_mfma_f32_32x32x16_bf16(b0,qr[d0],p0,0,0,0);p1=__builtin_amdgcn_mfma_f32_32x32x16_bf16(b1,qr[d0],p1,0,0,0);}}
}
typedef __attribute__((address_space(3))) const char* lds_cptr;
typedef short v4i16_t __attribute__((ext_vector_type(4)));
__device__ __forceinline__ void kload8(bf16x8*kf,lds_cptr kp){
  kf[0]=*(const __attribute__((address_space(3))) bf16x8*)(kp);      kf[1]=*(const __attribute__((address_space(3))) bf16x8*)(kp+512);
  kf[2]=*(const __attribute__((address_space(3))) bf16x8*)(kp+2048); kf[3]=*(const __attribute__((address_space(3))) bf16x8*)(kp+2560);
  kf[4]=*(const __attribute__((address_space(3))) bf16x8*)(kp+4096); kf[5]=*(const __attribute__((address_space(3))) bf16x8*)(kp+4608);
  kf[6]=*(const __attribute__((address_space(3))) bf16x8*)(kp+6144); kf[7]=*(const __attribute__((address_space(3))) bf16x8*)(kp+6656);
}
__device__ __forceinline__ void kload2(bf16x8*kf,lds_cptr kp,int j){ kf[2*j]=*(const __attribute__((address_space(3))) bf16x8*)(kp+j*2048); kf[2*j+1]=*(const __attribute__((address_space(3))) bf16x8*)(kp+j*2048+512); }
__device__ __forceinline__ s16x4 vtr(lds_cptr p){ return __builtin_bit_cast(s16x4,__builtin_amdgcn_ds_read_tr16_b64_v4i16((__attribute__((address_space(3))) v4i16_t*)p)); }
__device__ __forceinline__ float rowmax(const f32x16&p0,const f32x16&p1){
  float a=max3f(p0[0],p0[1],p1[0]),b=max3f(p0[2],p0[3],p1[1]);a=max3f(a,p1[2],p1[3]);
  #pragma unroll
  for(int r=4;r<16;r+=4){a=max3f(a,p0[r],p0[r+1]);b=max3f(b,p0[r+2],p0[r+3]);a=max3f(a,p1[r],p1[r+1]);b=max3f(b,p1[r+2],p1[r+3]);}
  const float m=max2f(a,b);
  auto rr=__builtin_amdgcn_permlane32_swap(__float_as_uint(m),__float_as_uint(m),false,false);
  return max2f(__uint_as_float(rr[0]),__uint_as_float(rr[1]));
}
__device__ __forceinline__ void pv(f32x16*o,int vb,bf16x8 pa0,bf16x8 pa1,bf16x8 pa2,bf16x8 pa3){
  #pragma unroll
  for(int d0=0;d0<2;++d0){s16x4 lo[4],hi[4];
    #pragma unroll
    for(int ks=0;ks<4;++ks){
      asm volatile("ds_read_b64_tr_b16 %0,%1 offset:%c2":"=&v"(lo[ks]):"v"(vb),"i"(d0*4096+ks*1024):"memory");
      asm volatile("ds_read_b64_tr_b16 %0,%1 offset:%c2":"=&v"(hi[ks]):"v"(vb),"i"(d0*4096+ks*1024+512):"memory");}
    asm volatile("s_waitcnt lgkmcnt(0)":::"memory");SBAR();
    #define PK(k) (bf16x8){lo[k][0],lo[k][1],lo[k][2],lo[k][3],hi[k][0],hi[k][1],hi[k][2],hi[k][3]}
    o[d0]=__builtin_amdgcn_mfma_f32_32x32x16_bf16(pa0,PK(0),o[d0],0,0,0);
    o[d0]=__builtin_amdgcn_mfma_f32_32x32x16_bf16(pa1,PK(1),o[d0],0,0,0);
    o[d0]=__builtin_amdgcn_mfma_f32_32x32x16_bf16(pa2,PK(2),o[d0],0,0,0);
    o[d0]=__builtin_amdgcn_mfma_f32_32x32x16_bf16(pa3,PK(3),o[d0],0,0,0);
    #undef PK
  }
}

#ifndef ATTN_STORE16
#define ATTN_STORE16(p,v) (*(u32x4*)(p)=(v))
#endif
template<int THRL,int QM,int EPI,int DK=64,bool NOMAX=false,int HS=32,bool KTL=false> __device__ __forceinline__ void attn_unit(const bf16*Qw0,int qp,const bf16*__restrict__ Kh,int kp,const bf16*__restrict__ Vh,int vp,bf16*Ow0,int op,const int NT,char*shm,float lam,float oml,const float*gsub,const bf16*__restrict__ Kh2=nullptr,int kp2=0,const f32x2_t*rope=nullptr,int qpos0=-1){
  constexpr int qmask=QM, epi=EPI; constexpr int NS=DK/16, NKP=DK/8, SLOTK=NKP*1024;
  constexpr int L_K=0, L_V=NSLOT*SLOTK, L_WS=L_V+NSLOT*SLOTB, L_OST=L_WS+NW*64*4, L_STASH=L_OST+NW*4096;
  #define KOFF(sl) (((sl)>>13)*SLOTK)
  int tid_=threadIdx.x; asm volatile("":"+v"(tid_)); const int tid=tid_,lane=tid&63,r32=lane&31,hi=lane>>5; const int wid=__builtin_amdgcn_readfirstlane(tid>>6);
  const bf16*Qw=Qw0+(long)(wid*QBLK)*qp;
  const unsigned lds0=(unsigned)(uintptr_t)shm;
  float*wsf=(float*)(shm+L_WS)+wid*64;
  const bf16*ksrc=KTL?(Kh+wid*512+lane*8):(Kh+(long)lane*kp+(wid&3)*8+(wid>>2)*HS);
  const bf16*ksrc2=Kh2+(long)lane*kp2+wid*8; const long kstep2=(long)KVBLK*kp2;
  const bf16*vsrc=Vh+(long)(16*(wid&3)+(lane>>2))*vp+(wid>>2)*HS+(lane&3)*8;
  const long kstep=KTL?4096L:(long)KVBLK*kp, vstep=(long)KVBLK*vp;
  const unsigned kdst=lds0+L_K+wid*1024, vdst=lds0+L_V+wid*1024;
  #define DMA_K(t,slot) do{ glds16(ksrc+(long)(t)*kstep,(unsigned)__builtin_amdgcn_readfirstlane(kdst+KOFF(slot))); \
      if constexpr(NKP>8){ if(wid<NKP-8) glds16(ksrc2+(long)(t)*kstep2,(unsigned)__builtin_amdgcn_readfirstlane(kdst+KOFF(slot)+8192)); } }while(0)
  #define WAITB2() do{ if constexpr(NKP>8){ if(wid<NKP-8){WAIT_BAR(3);} else {WAIT_BAR(2);} } else {WAIT_BAR(2);} }while(0)
  #define DMA_V(t,slot) glds16(vsrc+(long)(t)*vstep,(unsigned)__builtin_amdgcn_readfirstlane(vdst+(slot)))
  const int vb0=(int)(lds0+L_V)+((lane>>4)&1)*32+(lane&3)*8+(4*hi+((lane&15)>>2))*64;
  const char*Kbase=shm+L_K; bf16x8 kf[NKP];
  const lds_cptr shm3=(lds_cptr)shm; const lds_cptr kp0=shm3+L_K+hi*1024+r32*16; const lds_cptr vp0=shm3+L_V+((lane>>4)&1)*32+(lane&3)*8+(4*hi+((lane&15)>>2))*64;
  DMA_K(0,0);DMA_V(0,0);DMA_K(1,SLOTB);
  bf16x8 qr[NS];
  #pragma unroll
  for(int d0=0;d0<NS;++d0)qr[d0]=*reinterpret_cast<const bf16x8*>(&Qw[(long)r32*qp+(d0>>1)*HS+(d0&1)*16+hi*8]);
  if constexpr(DK==96){
    if(qpos0==-2){qr[4]=bf16x8{};qr[5]=bf16x8{};}
    else if(qpos0>=0){ const int s_=qpos0+wid*QBLK+r32;
      _Pragma("unroll") for(int k=0;k<2;++k){ const int i0=8*k+4*hi; const f32x2_t*cs=rope+(i0<8?(s_>>6):(s_&63))*8+(i0&7);
        const u32x4 w=__builtin_bit_cast(u32x4,qr[4+k]); const unsigned ww[4]={w.x,w.y,w.z,w.w}; unsigned oo[4];
        _Pragma("unroll") for(int j=0;j<4;++j){ const f32x2_t c=cs[j]; const float x1=__uint_as_float(ww[j]<<16),x2=__uint_as_float(ww[j]&0xffff0000u); oo[j]=cvtpk_s(x1*c.x-x2*c.y,x1*c.y+x2*c.x); }
        const u32x4 o_={oo[0],oo[1],oo[2],oo[3]}; qr[4+k]=__builtin_bit_cast(bf16x8,o_); } } }
  if(qmask==1){qr[2]=bf16x8{};qr[3]=bf16x8{};} if(qmask==2){qr[0]=bf16x8{};qr[1]=bf16x8{};}
  float mhat=0.f,l_reg=0.f;f32x16 o[2];o[0]=f32x16{};o[1]=f32x16{};f32x16 negm=f32x16{}; if constexpr(!NOMAX) asm volatile("":"+v"(negm));
  #define CMASK(P0,P1,t) do{}while(0)
  bool resc=false;
  #define START(P0,P1) do{ resc=false; if constexpr(!NOMAX) { const float rm=rowmax(P0,P1); \
    { const float dl=rm; mhat=fadd_s(mhat,dl); \
      _Pragma("unroll") for(int r=0;r<16;++r){P0[r]=fsub_s(P0[r],dl);P1[r]=fsub_s(P1[r],dl);} \
      _Pragma("unroll") for(int r=0;r<16;++r)negm[r]=-mhat; asm volatile("":"+v"(negm)); } } \
    _Pragma("unroll") for(int r=0;r<16;++r)P0[r]=__builtin_amdgcn_exp2f(P0[r]); }while(0)
  #define RESC() do{ if(resc){ asm volatile("s_waitcnt lgkmcnt(0)":::"memory"); \
      _Pragma("unroll") for(int d_=0;d_<2;++d_) _Pragma("unroll") for(int r=0;r<16;++r)o[d_][r]*=wsf[crow(r,hi)]; } }while(0)
  f32x16 pA0,pA1,pB0,pB1;
  int sl_prev=0,sl_cur=0,sl_next=SLOTB;
  #define ROT() do{sl_prev=sl_cur;sl_cur=sl_next;sl_next=(sl_next==(NSLOT-1)*SLOTB)?0:sl_next+SLOTB;}while(0)
  DMA_K(2,2*SLOTB);
  if constexpr(NKP>8){ if(wid<NKP-8){WAIT_BAR(5);} else {WAIT_BAR(3);} } else {WAIT_BAR(3);}
  qkt<NS>(pA0,pA1,Kbase,qr,negm,r32,hi);asm volatile("s_nop 15\n\ts_nop 7":"+v"(pA0),"+v"(pA1));CMASK(pA0,pA1,0);
  START(pA0,pA1);
  _Pragma("unroll") for(int r=0;r<16;++r)pA1[r]=__builtin_amdgcn_exp2f(pA1[r]);
  WAIT_BAR(0);
  DMA_K(3,0);DMA_V(1,SLOTB);
  ROT();
  _Pragma("unroll") for(int j=0;j<NS;++j){ if constexpr(QM==1){ if(j>=2&&j<4)continue; } if constexpr(QM==2){ if(j<2)continue; } kload2(kf,kp0+KOFF(sl_cur),j); }
  WAITB2();
  s16x4 vlo[8],vhi[8]; u32x4 pw0,pw1,pw2,pw3;
  #define PKW(P,B) cvtpk_s(P[B],P[B+1])
  #define PAF(k) __builtin_bit_cast(bf16x8,pw##k)
  #define VFR(i) (bf16x8){vlo[i][0],vlo[i][1],vlo[i][2],vlo[i][3],vhi[i][0],vhi[i][1],vhi[i][2],vhi[i][3]}
  #define PIN(x) asm volatile("":"+v"(x))
  #define MX3(a,b,c) __builtin_fmaxf(__builtin_fmaxf((a),(b)),(c))
  #define GAPA(MF,A0,A1,A2,A3,W0,W1,PW) do{ MF; sacc+=A0; sacc2+=A1; sacc+=A2; sacc2+=A3; PIN(sacc); PIN(sacc2); W0; W1; PIN(PW); SBAR(); }while(0)
  #define EX(v) __builtin_amdgcn_exp2f(v)
  #define GAPB(MF,X,B) do{ MF; X[B]=EX(X[B]); X[B+1]=EX(X[B+1]); X[B+2]=EX(X[B+2]); X[B+3]=EX(X[B+3]); PIN(X); SBAR(); }while(0)
  #define VRD(i) do{ vlo[i]=vtr(vp_+(((i)>>2)*4096+((i)&3)*1024)); vhi[i]=vtr(vp_+(((i)>>2)*4096+((i)&3)*1024+512)); }while(0)
  #define KRD(G,j) do{ if constexpr(!((QM==1&&(j)>=2&&(j)<4)||(QM==2&&(j)<2))){ if(G){ kload2(kf,kp0+KOFF(sl_next),j); SBAR(); } } }while(0)
  #define MFLO(C,ki,qi,init) do{ if constexpr(QM!=2){ C=__builtin_amdgcn_mfma_f32_32x32x16_bf16(kf[ki],qr[qi],init,0,0,0); } }while(0)
  #define MFHI0(C,ki,qi) do{ if constexpr(QM==2){ C=__builtin_amdgcn_mfma_f32_32x32x16_bf16(kf[ki],qr[qi],negm,0,0,0); } else if constexpr(QM==0){ C=__builtin_amdgcn_mfma_f32_32x32x16_bf16(kf[ki],qr[qi],C,0,0,0); } }while(0)
  #define MFHI1(C,ki,qi) do{ if constexpr(QM!=1){ C=__builtin_amdgcn_mfma_f32_32x32x16_bf16(kf[ki],qr[qi],C,0,0,0); } }while(0)
  #define STEP(C0,C1,P0,P1,t,GK,GV,GL) do{ SBAR(); \
    const lds_cptr vp_=vp0+sl_prev; \
    VRD(0); SBAR(); float sacc=P0[0], sacc2=P0[1]; \
    GAPA(MFLO(C0,0,0,negm), P0[2],P0[3],P0[4],P0[5],     pw0[0]=PKW(P0,0), pw0[1]=PKW(P0,2), pw0); \
    VRD(4); SBAR(); GAPA(MFLO(C1,1,0,negm), P0[6],P0[7],P0[8],P0[9],     pw0[2]=PKW(P0,4), pw0[3]=PKW(P0,6), pw0); \
    VRD(1); SBAR(); GAPA(MFLO(C0,2,1,C0),   P0[10],P0[11],P0[12],P0[13], pw1[0]=PKW(P0,8), pw1[1]=PKW(P0,10), pw1); \
    VRD(5); SBAR(); GAPA(MFLO(C1,3,1,C1),   P0[14],P0[15],P1[0],P1[1],   pw1[2]=PKW(P0,12),pw1[3]=PKW(P0,14), pw1); \
    VRD(2); SBAR(); GAPA(MFHI0(C0,4,2),   P1[2],P1[3],P1[4],P1[5],     pw2[0]=PKW(P1,0), pw2[1]=PKW(P1,2), pw2); \
    VRD(6); SBAR(); GAPA(MFHI0(C1,5,2),   P1[6],P1[7],P1[8],P1[9],     pw2[2]=PKW(P1,4), pw2[3]=PKW(P1,6), pw2); \
    VRD(3); SBAR(); GAPA(MFHI1(C0,6,3),   P1[10],P1[11],P1[12],P1[13], pw3[0]=PKW(P1,8), pw3[1]=PKW(P1,10), pw3); \
    VRD(7); SBAR(); GAPA(MFHI1(C1,7,3),   P1[14],P1[15],0.f,0.f,       pw3[2]=PKW(P1,12),pw3[3]=PKW(P1,14), pw3); \
    if constexpr(DK==96){ C0=__builtin_amdgcn_mfma_f32_32x32x16_bf16(kf[8],qr[4],C0,0,0,0); C1=__builtin_amdgcn_mfma_f32_32x32x16_bf16(kf[9],qr[4],C1,0,0,0); \
                          C0=__builtin_amdgcn_mfma_f32_32x32x16_bf16(kf[10],qr[5],C0,0,0,0); C1=__builtin_amdgcn_mfma_f32_32x32x16_bf16(kf[11],qr[5],C1,0,0,0); SBAR(); } \
    l_reg+=(sacc+sacc2); \
    if(GK){DMA_K((t)+3,sl_cur);} if(GV){DMA_V((t)+1,sl_next);} \
    CMASK(C0,C1,t); \
    if constexpr(NOMAX){ resc=false; } else { float a=MX3(C0[0],C0[1],C1[0]),b=MX3(C0[2],C0[3],C1[1]); a=MX3(a,C1[2],C1[3]); \
      _Pragma("unroll") for(int r=4;r<16;r+=4){a=MX3(a,C0[r],C0[r+1]);b=MX3(b,C0[r+2],C0[r+3]);a=MX3(a,C1[r],C1[r+1]);b=MX3(b,C1[r+2],C1[r+3]);} \
      float rm=__builtin_fmaxf(a,b); { auto rr=__builtin_amdgcn_permlane32_swap(__float_as_uint(rm),__float_as_uint(rm),false,false); rm=__builtin_fmaxf(__uint_as_float(rr[0]),__uint_as_float(rr[1])); } \
      resc=false; \
      if(__builtin_expect(__any(rm>(float)THRL),0)){ const float dl=__builtin_fmaxf(rm,0.f); mhat+=dl; \
        _Pragma("unroll") for(int r=0;r<16;++r){C0[r]-=dl;C1[r]-=dl;} \
        _Pragma("unroll") for(int r=0;r<16;++r)negm[r]=-mhat; asm volatile("":"+v"(negm)); \
        const float f=__builtin_amdgcn_exp2f(-dl); l_reg*=f; if(hi==0)wsf[r32]=f; resc=true; } } \
    SBAR(); \
    GAPB(o[0]=__builtin_amdgcn_mfma_f32_32x32x16_bf16(PAF(0),VFR(0),o[0],0,0,0), C0,0); \
    GAPB(o[1]=__builtin_amdgcn_mfma_f32_32x32x16_bf16(PAF(0),VFR(4),o[1],0,0,0), C0,4); \
    KRD(GL,0); GAPB(o[0]=__builtin_amdgcn_mfma_f32_32x32x16_bf16(PAF(1),VFR(1),o[0],0,0,0), C0,8); \
    KRD(GL,1); GAPB(o[1]=__builtin_amdgcn_mfma_f32_32x32x16_bf16(PAF(1),VFR(5),o[1],0,0,0), C0,12); \
    KRD(GL,2); GAPB(o[0]=__builtin_amdgcn_mfma_f32_32x32x16_bf16(PAF(2),VFR(2),o[0],0,0,0), C1,0); \
    KRD(GL,3); GAPB(o[1]=__builtin_amdgcn_mfma_f32_32x32x16_bf16(PAF(2),VFR(6),o[1],0,0,0), C1,4); \
    if constexpr(DK==96){ KRD(GL,4); } GAPB(o[0]=__builtin_amdgcn_mfma_f32_32x32x16_bf16(PAF(3),VFR(3),o[0],0,0,0), C1,8); \
    if constexpr(DK==96){ KRD(GL,5); } GAPB(o[1]=__builtin_amdgcn_mfma_f32_32x32x16_bf16(PAF(3),VFR(7),o[1],0,0,0), C1,12); \
    }while(0)
  int t=1;
  for(;t+5<NT;t+=2){
    STEP(pB0,pB1,pA0,pA1,t,true,true,true);     WAITB2(); RESC(); ROT();
    STEP(pA0,pA1,pB0,pB1,t+1,true,true,true);   WAITB2(); RESC(); ROT();
  }
  #define ENDW(tt) do{ if((tt)+3<NT){WAITB2();} else if((tt)+2<NT){WAIT_BAR(1);} else {WAIT_BAR(0);} }while(0)
  for(;t+1<NT;t+=2){
    STEP(pB0,pB1,pA0,pA1,t,(t+3<NT),(t+1<NT),(t+1<NT));       ENDW(t);   RESC(); ROT();
    STEP(pA0,pA1,pB0,pB1,t+1,(t+4<NT),(t+2<NT),(t+2<NT));     ENDW(t+1); RESC(); ROT();
  }
  STEP(pB0,pB1,pA0,pA1,NT-1,false,false,false); RESC();
  { float sacc=pB0[0]+pB0[1]; _Pragma("unroll") for(int r=2;r<16;++r)sacc+=pB0[r]; _Pragma("unroll") for(int r=0;r<16;++r)sacc+=pB1[r]; l_reg+=sacc;
    pw0=(u32x4){PKW(pB0,0),PKW(pB0,2),PKW(pB0,4),PKW(pB0,6)};pw1=(u32x4){PKW(pB0,8),PKW(pB0,10),PKW(pB0,12),PKW(pB0,14)};pw2=(u32x4){PKW(pB1,0),PKW(pB1,2),PKW(pB1,4),PKW(pB1,6)};pw3=(u32x4){PKW(pB1,8),PKW(pB1,10),PKW(pB1,12),PKW(pB1,14)};
    SBAR(); pv(o,vb0+sl_cur,PAF(0),PAF(1),PAF(2),PAF(3)); }
  #undef PKW
  #undef PAF
  #undef VFR
  #undef PIN
  #undef MX3
  #undef GAPA
  #undef GAPB
  #undef EX
  #undef VRD
  #undef KRD
  #undef STEP
  #undef MFLO
  #undef MFHI0
  #undef MFHI1
  #undef ENDW
  #undef KOFF
  #undef WAITB2
  {auto rr=__builtin_amdgcn_permlane32_swap(__float_as_uint(l_reg),__float_as_uint(l_reg),false,false);l_reg=__uint_as_float(rr[0])+__uint_as_float(rr[1]);}
  if(hi==0)wsf[32+r32]=l_reg;asm volatile("s_waitcnt lgkmcnt(0)":::"memory");
  float rli[16];
  #pragma unroll
  for(int r=0;r<16;++r)rli[r]=__builtin_amdgcn_rcpf(wsf[32+crow(r,hi)]);
  bf16*Ow=Ow0+(long)(wid*QBLK)*op;
  { bf16*stg=(bf16*)(shm+(epi==1?L_STASH:L_OST))+wid*2048;
    #pragma unroll
    for(int r=0;r<16;++r){const int orow=crow(r,hi);
      #pragma unroll
      for(int d0=0;d0<2;++d0)stg[orow*64+d0*32+r32]=__float2bfloat16(o[d0][r]*rli[r]);}
    asm volatile("s_waitcnt lgkmcnt(0)":::"memory");
    if(epi==0){
      #pragma unroll
      for(int i=0;i<4;++i){const int row=i*8+(lane>>3),ch=lane&7; const u32x4 v=*(const u32x4*)(stg+row*64+ch*8); ATTN_STORE16(Ow+(long)row*op+ch*8,v);}
    } else if(epi==2){
      const bf16*sth=(const bf16*)(shm+L_STASH)+wid*2048; const int ch=lane&7; float gs[8];
      #pragma unroll
      for(int k=0;k<8;++k)gs[k]=gsub[ch*8+k]*oml;
      #pragma unroll
      for(int i=0;i<4;++i){const int row=i*8+(lane>>3); const u32x4 v1=*(const u32x4*)(stg+row*64+ch*8), v0=*(const u32x4*)(sth+row*64+ch*8);
        float a[8]; const unsigned w0[4]={v0.x,v0.y,v0.z,v0.w}, w1[4]={v1.x,v1.y,v1.z,v1.w}; float ss=0.f;
        #pragma unroll
        for(int k=0;k<4;++k){ a[2*k]=__uint_as_float(w0[k]<<16)-lam*__uint_as_float(w1[k]<<16); a[2*k+1]=__uint_as_float(w0[k]&0xffff0000u)-lam*__uint_as_float(w1[k]&0xffff0000u); ss+=a[2*k]*a[2*k]+a[2*k+1]*a[2*k+1]; }
        ss+=__builtin_bit_cast(float,__builtin_amdgcn_ds_swizzle(__builtin_bit_cast(int,ss),(1<<10)|0x1f)); ss+=__builtin_bit_cast(float,__builtin_amdgcn_ds_swizzle(__builtin_bit_cast(int,ss),(2<<10)|0x1f)); ss+=__builtin_bit_cast(float,__builtin_amdgcn_ds_swizzle(__builtin_bit_cast(int,ss),(4<<10)|0x1f));
        const float rstd=1.0f/sqrtf(ss*(1.f/64.f)+1e-6f);
        u32x4 ov; ov.x=cvtpk_s(a[0]*rstd*gs[0],a[1]*rstd*gs[1]); ov.y=cvtpk_s(a[2]*rstd*gs[2],a[3]*rstd*gs[3]); ov.z=cvtpk_s(a[4]*rstd*gs[4],a[5]*rstd*gs[5]); ov.w=cvtpk_s(a[6]*rstd*gs[6],a[7]*rstd*gs[7]);
        ATTN_STORE16(Ow+(long)row*op+ch*8,ov);}
    } }
  asm volatile("s_waitcnt lgkmcnt(0)\n\ts_barrier":::"memory");
  #undef DMA_K
  #undef DMA_V
  #undef CMASK
  #undef START
  #undef RESC
  #undef ROT
}
constexpr int ATTN_LDS_BYTES=LDS_BYTES;
#undef SBAR
#undef WAIT_BAR
}

constexpr size_t MiB = 1u << 20;
constexpr size_t WS_CTL = 0, CTL_ZERO_BYTES = 64 * 1024;
constexpr size_t WS_MODV = 1 * MiB;
constexpr size_t WS_ROPEA = 1 * MiB + 448 * 1024;
constexpr size_t WS_ROPEB = 1 * MiB + 456 * 1024;
constexpr size_t WS_LAM = 1 * MiB + 460 * 1024;
constexpr size_t WS_BND = 1 * MiB + 464 * 1024;
constexpr size_t WS_WIN = 2 * MiB;
constexpr size_t WS_WOUT = 10 * MiB;
constexpr size_t WS_WU = 14 * MiB;
constexpr size_t WS_WUKV = 15 * MiB;
constexpr size_t WS_FIN = 16 * MiB;
constexpr size_t WS_FOUT = 27 * MiB;
constexpr size_t WS_X = 34 * MiB;
constexpr size_t WS_QM = 170 * MiB;
constexpr size_t WS_KN = 196 * MiB;
constexpr size_t WS_VM = 213 * MiB;
constexpr size_t WS_MIN = 170 * MiB;
constexpr size_t WS_MOUT = 226 * MiB;
constexpr size_t WS_H = 254 * MiB;
constexpr size_t WS_P = 322 * MiB;
constexpr size_t WS_ACT = 322 * MiB;
constexpr size_t WS_ACTC = 254 * MiB;
constexpr size_t WS_FIN8 = 102 * MiB;
constexpr size_t WS_FOUT8 = 108 * MiB;
constexpr size_t WS_H8 = 111 * MiB;
constexpr size_t WS_ACT8 = 113 * MiB;
constexpr size_t WS_MS = 120 * MiB;
constexpr size_t WS_KTG = 124 * MiB;
constexpr size_t WS_AMOE8 = 102 * MiB;
constexpr size_t WS_TOKE = 378 * MiB;
constexpr size_t WS_TOKW = 378 * MiB + 256 * 1024;
constexpr size_t WS_TOKS = 378 * MiB + 512 * 1024;
constexpr size_t WS_TILEE = 378 * MiB + 768 * 1024;
constexpr size_t WS_AMOE = 380 * MiB;
constexpr size_t WS_END = 512 * MiB;
constexpr int CW_BAR = 4096, CW_CNT = 8192, CW_FILL = 8192 + 512, CW_HO = 12288;
constexpr int RING_BYTES = 131072, LDSCTL_OFF = RING_BYTES, MISC_OFF = LDSCTL_OFF + 320, LDS_BYTES = 147456;
constexpr int NWAVES = 8;

#define XB_TMO      128
#define XB_XCNT(j)  (256  + 64 * (j))
#define XB_XSUB(j)  (1280 + 64 * (j))
#define XB_XGEN(j)  (2304 + 64 * (j))
#define XB_TOP      3328
#define XB_TOPGEN   3392
#define XCD_BAR_WORDS 3456
#define XB_SPIN_CAP (1u << 18)
__device__ __forceinline__ unsigned xb_ld(unsigned* p)              { return __hip_atomic_load(p, __ATOMIC_RELAXED, __HIP_MEMORY_SCOPE_AGENT); }
__device__ __forceinline__ unsigned xb_add(unsigned* p, unsigned v) { return __hip_atomic_fetch_add(p, v, __ATOMIC_RELAXED, __HIP_MEMORY_SCOPE_AGENT); }
__device__ __forceinline__ unsigned xb_xcc_id() { return (unsigned)__builtin_amdgcn_s_getreg((3 << 11) | 20) & 0xFu; }
#define XB_SPIN(cond, bar) do { unsigned _sp = 0; while (cond) { __builtin_amdgcn_s_sleep(1); \
    if ((++_sp & 255u) == 0u) { if (xb_ld(&(bar)[XB_TMO])) break; if (_sp > XB_SPIN_CAP) { atomicAdd(&(bar)[XB_TMO], 1u); break; } } } } while (0)
struct XcdBarrier { unsigned* bar; unsigned x; volatile LAS unsigned* st; };
__device__ __forceinline__ XcdBarrier xcd_barrier_post(unsigned* bar, volatile LAS unsigned* st) {
    XcdBarrier b; b.bar = bar; b.x = xb_xcc_id(); b.st = st;
    if (threadIdx.x == 0) (void)xb_add(&bar[XB_XCNT(b.x)], 1u);
    return b;
}
__device__ __forceinline__ void xcd_barrier_complete(unsigned* bar, unsigned x, unsigned& nloc, unsigned& nx) {
    const unsigned G = gridDim.x * gridDim.y * gridDim.z;
    unsigned sum, cnt, mine, sp = 0u;
    for (;;) {
        sum = 0u; cnt = 0u; mine = 0u;
#pragma unroll
        for (unsigned j = 0; j < 16; ++j) { const unsigned c = xb_ld(&bar[XB_XCNT(j)]); sum += c; cnt += (c > 0u) ? 1u : 0u; mine = (j == x) ? c : mine; }
        if (sum == G) break;
        __builtin_amdgcn_s_sleep(1);
        if ((++sp & 255u) == 0u) { if (xb_ld(&bar[XB_TMO])) break; if (sp > XB_SPIN_CAP) { atomicAdd(&bar[XB_TMO], 1u); break; } }
    }
    nloc = mine > 0u ? mine : 1u; nx = cnt > 0u ? cnt : 1u;
}
__device__ __forceinline__ void xcd_barrier(const XcdBarrier& b) {
    asm volatile("s_waitcnt vmcnt(0)" ::: "memory");
    __syncthreads();
    if (threadIdx.x == 0) {
        unsigned* bar = b.bar;
        __builtin_amdgcn_s_waitcnt(0);
        unsigned nloc = b.st[0], nx = b.st[1];
        if (nloc == 0u) { xcd_barrier_complete(bar, b.x, nloc, nx); b.st[0] = nloc; b.st[1] = nx; }
        const unsigned old = xb_add(&bar[XB_XSUB(b.x)], 1u);
        const unsigned gen = old / nloc;
        if (old + 1u == (gen + 1u) * nloc) {
            __builtin_amdgcn_fence(__ATOMIC_RELEASE, "agent");
            asm volatile("s_waitcnt vmcnt(0)" ::: "memory");
            const unsigned og = xb_add(&bar[XB_TOP], 1u);
            const unsigned tg = og / nx;
            if (og + 1u == (tg + 1u) * nx) xb_add(&bar[XB_TOPGEN], 1u);
            else XB_SPIN(xb_ld(&bar[XB_TOPGEN]) == tg, bar);
            __builtin_amdgcn_fence(__ATOMIC_ACQUIRE, "agent");
            xb_add(&bar[XB_XGEN(b.x)], 1u);
            asm volatile("s_waitcnt vmcnt(0)" ::: "memory");
        } else {
            XB_SPIN(xb_ld(&bar[XB_XGEN(b.x)]) == gen, bar);
            __builtin_amdgcn_fence(__ATOMIC_ACQUIRE, "agent");
            asm volatile("s_waitcnt vmcnt(0)" ::: "memory");
        }
    }
    __syncthreads();
}

__device__ __forceinline__ void ctx_handoff(unsigned* ctl, int slot) {
    asm volatile("s_waitcnt vmcnt(0)" ::: "memory");
    __syncthreads();
    if (threadIdx.x == 0) {
        unsigned* bar = ctl + CW_BAR; unsigned* w = ctl + CW_HO + 64 * slot;
        __builtin_amdgcn_fence(__ATOMIC_RELEASE, "agent");
        asm volatile("s_waitcnt vmcnt(0)" ::: "memory");
        (void)xb_add(w, 1u);
        XB_SPIN(xb_ld(w) < 4u, bar);
        __builtin_amdgcn_fence(__ATOMIC_ACQUIRE, "agent");
        asm volatile("s_waitcnt vmcnt(0)" ::: "memory");
    }
    __syncthreads();
}

#define SWZ_XOR(v, X) __builtin_bit_cast(float, __builtin_amdgcn_ds_swizzle(__builtin_bit_cast(int, (v)), ((X) << 10) | 0x1f))
__device__ __forceinline__ float group8_sum(float v) { v += SWZ_XOR(v, 1); v += SWZ_XOR(v, 2); v += SWZ_XOR(v, 4); return v; }
__device__ __forceinline__ float wave_sum(float v) {
    v += SWZ_XOR(v, 1); v += SWZ_XOR(v, 2); v += SWZ_XOR(v, 4); v += SWZ_XOR(v, 8); v += SWZ_XOR(v, 16);
    auto rr = __builtin_amdgcn_permlane32_swap(__float_as_uint(v), __float_as_uint(v), false, false);
    return __uint_as_float(rr[0]) + __uint_as_float(rr[1]);
}
__device__ __forceinline__ float wave_max(float v) {
    v = fmaxf(v, SWZ_XOR(v, 1)); v = fmaxf(v, SWZ_XOR(v, 2)); v = fmaxf(v, SWZ_XOR(v, 4)); v = fmaxf(v, SWZ_XOR(v, 8)); v = fmaxf(v, SWZ_XOR(v, 16));
    auto rr = __builtin_amdgcn_permlane32_swap(__float_as_uint(v), __float_as_uint(v), false, false);
    return fmaxf(__uint_as_float(rr[0]), __uint_as_float(rr[1]));
}
__device__ __forceinline__ void unpack8(const u32x4 w, float (&v)[8]) { v[0] = bflo(w.x); v[1] = bfhi(w.x); v[2] = bflo(w.y); v[3] = bfhi(w.y); v[4] = bflo(w.z); v[5] = bfhi(w.z); v[6] = bflo(w.w); v[7] = bfhi(w.w); }
__device__ __forceinline__ u32x4 pack8f(const float (&v)[8]) { u32x4 w; w.x = cvtpk(v[0], v[1]); w.y = cvtpk(v[2], v[3]); w.z = cvtpk(v[4], v[5]); w.w = cvtpk(v[6], v[7]); return w; }
__device__ __forceinline__ void rope4(float (&v)[8], const f32x2* cs) {
#pragma unroll
    for (int k = 0; k < 4; ++k) { const f32x2 c = cs[k]; const float x1 = v[2 * k], x2 = v[2 * k + 1]; v[2 * k] = x1 * c.x - x2 * c.y; v[2 * k + 1] = x1 * c.y + x2 * c.x; }
}
__device__ __forceinline__ void sincos_small(float a, float& sn, float& cs) {
    const float n = rintf(a * 0.6366197723675814f);
    float r = fmaf(-n, 1.5703125f, a); r = fmaf(-n, 4.837512969970703125e-4f, r); r = fmaf(-n, 7.54978995489188216e-8f, r);
    const float z = r * r;
    const float s = r + r * z * ((-1.9515295891e-4f * z + 8.3321608736e-3f) * z - 1.6666654611e-1f);
    const float c = 1.0f - 0.5f * z + z * z * ((2.443315711809948e-5f * z - 1.388731625493765e-3f) * z + 4.166664568298827e-2f);
    const int q = ((int)n) & 3;
    sn = (q == 0) ? s : (q == 1) ? c : (q == 2) ? -s : -c;
    cs = (q == 0) ? c : (q == 1) ? -s : (q == 2) ? -c : s;
}

template <bool OUT8 = false> __device__ __forceinline__ void transpose_item(const float* W, int K, int N, void* WTv, int mode, int F, LAS float* scr, int item, int lane) {
    const int nblk = N / 32, kb = item / nblk, nb = item % nblk, k0 = 64 * kb, n0 = 32 * nb;
    int rout = n0;
    if (mode == 1) { if (n0 < F) rout = 256 * (n0 / 128) + (n0 % 128); else { const int n1 = n0 - F; rout = 256 * (n1 / 128) + 128 + (n1 % 128); } }
    if (mode == 2) {
        const int hf = (n0 >> 5) & 1;
        if (n0 < 512) { const int h = n0 >> 6; rout = 256 * (h >> 2) + 32 * (h & 3) + 128 * hf; }
        else if (n0 < 640) { const int g2 = (n0 - 512) >> 6; rout = 512 + 32 * g2 + 128 * hf; }
        else if (n0 < 768) { const int g2 = (n0 - 640) >> 6; rout = 576 + 32 * g2 + 128 * hf; } }
#pragma unroll 8
    for (int i = 0; i < 32; ++i) { const int kk = 2 * i + (lane >> 5); scr[kk * 33 + (lane & 31)] = __builtin_nontemporal_load(W + (size_t)(k0 + kk) * N + n0 + (lane & 31)); }
    asm volatile("s_waitcnt lgkmcnt(0)" ::: "memory");
    const int c = lane & 7;
#pragma unroll
    for (int j = 0; j < 4; ++j) { const int n = (lane >> 3) + 8 * j; const LAS float* s = scr + (8 * c) * 33 + n;
        if constexpr (OUT8) { u32x2 o; o.x = cvt4_fp8(s[0 * 33] * W8_SCALE, s[1 * 33] * W8_SCALE, s[2 * 33] * W8_SCALE, s[3 * 33] * W8_SCALE); o.y = cvt4_fp8(s[4 * 33] * W8_SCALE, s[5 * 33] * W8_SCALE, s[6 * 33] * W8_SCALE, s[7 * 33] * W8_SCALE);
            *(u32x2*)((unsigned char*)WTv + (size_t)(rout + n) * K + k0 + 8 * c) = o; }
        else { u32x4 o; o.x = cvtpk(s[0 * 33], s[1 * 33]); o.y = cvtpk(s[2 * 33], s[3 * 33]); o.z = cvtpk(s[4 * 33], s[5 * 33]); o.w = cvtpk(s[6 * 33], s[7 * 33]);
            *(u32x4*)((bf16_t*)WTv + (size_t)(rout + n) * K + k0 + 8 * c) = o; } }
    asm volatile("s_waitcnt lgkmcnt(0)" ::: "memory");
}

__device__ __forceinline__ void row_load(f32x4 (&v)[4], const float* xrow, int lane) { const f32x4* xr = (const f32x4*)xrow + lane;
#pragma unroll
    for (int j = 0; j < 4; ++j) v[j] = __builtin_nontemporal_load(xr + 64 * j); }
__device__ __forceinline__ void row_load(f32x4 (&v)[4], const bf16_t* xrow, int lane) { const u32x2* xr = (const u32x2*)xrow + lane;
#pragma unroll
    for (int j = 0; j < 4; ++j) { const u32x2 w = __builtin_nontemporal_load(xr + 64 * j); v[j] = (f32x4){bflo(w.x), bfhi(w.x), bflo(w.y), bfhi(w.y)}; } }
template <bool OUT8 = false> __device__ __forceinline__ void normmod_row(const f32x4 (&v)[4], const float* g, const float* shift, const float* scale, void* orow, int lane, f32x4 (&hv)[4]) {
    float s = 0.f;
#pragma unroll
    for (int j = 0; j < 4; ++j) { s += (v[j].x * v[j].x + v[j].y * v[j].y) + (v[j].z * v[j].z + v[j].w * v[j].w); }
    const float rstd = 1.0f / sqrtf(wave_sum(s) * (1.f / DM) + NEPS);
#pragma unroll
    for (int j = 0; j < 4; ++j) { const f32x4 gg = ((const f32x4*)g)[lane + 64 * j], sh = ((const f32x4*)shift)[lane + 64 * j], sc = ((const f32x4*)scale)[lane + 64 * j];
        hv[j] = (v[j] * rstd * gg) * (1.0f + sc) + sh;
        if constexpr (OUT8) ((unsigned*)orow)[lane + 64 * j] = cvt4_fp8(hv[j].x, hv[j].y, hv[j].z, hv[j].w);
        else { u32x2 w; w.x = cvtpk(hv[j].x, hv[j].y); w.y = cvtpk(hv[j].z, hv[j].w); ((u32x2*)orow)[lane + 64 * j] = w; } }
}

struct Args { const float* in[27]; float* out; unsigned char* ws; };
constexpr int PTR_OFF = LDSCTL_OFF + 512;
__device__ __forceinline__ const float* inptr(LAS unsigned char* lds, int i) {
    const LAS unsigned* t = (const LAS unsigned*)(lds + PTR_OFF) + 2 * i; const unsigned lo = __builtin_amdgcn_readfirstlane(t[0]), hi = __builtin_amdgcn_readfirstlane(t[1]);
    return (const float*)(GAS const float*)(((unsigned long long)hi << 32) | (unsigned long long)lo);
}
#define INP(i) inptr(lds, (i))
#define WSB(name) GAS unsigned char* name = (GAS unsigned char*)wsbase; asm volatile("" : "+s"(name))
#define FRESH_IDS() int tid_l = threadIdx.x; asm volatile("" : "+v"(tid_l)); const int tid = tid_l, lane = tid & 63; (void)tid; (void)lane
#define GRID_BAR() do { XcdBarrier b_; GAS unsigned char* w_ = (GAS unsigned char*)wsbase; asm volatile("" : "+s"(w_)); b_.bar = (unsigned*)(w_ + WS_CTL) + CW_BAR; b_.x = xb_xcc_id(); b_.st = (volatile LAS unsigned*)(lds + MISC_OFF) + 8; xcd_barrier(b_); } while (0)
enum { I_X = 0, I_C, I_CTX, I_CCTX, I_WMOD, I_BMOD, I_GATTN, I_GFFN, I_WIN, I_WOUT, I_GQ, I_GK, I_LQ1, I_LK1, I_LQ2, I_LK2, I_GSUB, I_GCQ, I_GCKV, I_WUQ, I_WUKV, I_FWIN, I_FWOUT, I_ROUTER, I_MWIN, I_MWOUT, I_GFINAL };

template <int l> __device__ __forceinline__ void layer_body(unsigned char* wsbase, float* outbase, LAS unsigned char* lds, const int G, const int vcu, const int wave) {
    const int gw = vcu * NWAVES + wave, NGW = G * NWAVES;
        if (l == 0) {
            FRESH_IDS(); WSB(ws);
            const float* modl = (const float*)(ws + WS_MODV) + (size_t)l * 9 * 6144; bf16_t* HB = (bf16_t*)(ws + WS_H);
            const float* x_in = INP(I_X); const float* ctx_in = INP(I_CTX); const float* g_attn = INP(I_GATTN) + l * DM;
#define P1_SRC(r_) (((r_) % TROWS) < CTX ? ctx_in + ((size_t)((r_) / TROWS) * CTX + ((r_) % TROWS)) * DM : x_in + ((size_t)((r_) / TROWS) * SEQ + (((r_) % TROWS) - CTX)) * DM)
            f32x4 nv[4]; if (gw < MROWS) row_load(nv, P1_SRC(gw), lane);
            for (int r = gw; r < MROWS; r += NGW) {
                const int b = r / TROWS, j = r % TROWS;
                f32x4 v[4];
#pragma unroll
                for (int q = 0; q < 4; ++q) v[q] = nv[q];
                if (r + NGW < MROWS) row_load(nv, P1_SRC(r + NGW), lane);
                const float* mr = modl + (size_t)(j < CTX ? 8 : b) * 6144;
                f32x4 hv[4]; normmod_row(v, g_attn, mr, mr + DM, HB + (size_t)r * DM, lane, hv);
            }
#undef P1_SRC
        } else if ((int)blockIdx.x < 32) {
            const int c = (int)blockIdx.x, b = c & 7, pn = c >> 3;
            {
                WSB(ws);
                pg8::Gemm g{(const bf16_t*)(ws + WS_ACT8), (const bf16_t*)(ws + WS_FOUT8), DFF, DFF}; pg8::CtxOrder S{c, 1};
                pg8::EpiRes<true> E{nullptr, nullptr, (bf16_t*)(ws + WS_X), (const float*)(ws + WS_MODV), 5, W8_INV, TPB};
                pg8::gemm_phase<pg8::EpiRes<true>, pg8::CtxOrder, true, 1>(lds, g, S, E);
            }
            { WSB(ws); ctx_handoff((unsigned*)(ws + WS_CTL), 8 + b); }
            {
                FRESH_IDS(); WSB(ws);
                const float* mr = (const float*)(ws + WS_MODV) + (size_t)l * 9 * 6144 + (size_t)8 * 6144; const bf16_t* XW = (const bf16_t*)(ws + WS_X); bf16_t* HB = (bf16_t*)(ws + WS_H); const float* g_attn = INP(I_GATTN) + l * DM;
                const size_t r0 = (size_t)b * TROWS + 64 * pn + wave * 8;
                f32x4 nv[4]; row_load(nv, XW + r0 * DM, lane);
                for (int i = 0; i < 8; ++i) {
                    f32x4 v[4];
#pragma unroll
                    for (int q = 0; q < 4; ++q) v[q] = nv[q];
                    if (i + 1 < 8) row_load(nv, XW + (r0 + i + 1) * DM, lane);
                    f32x4 hv[4]; normmod_row(v, g_attn, mr, mr + DM, HB + (r0 + i) * DM, lane, hv);
                }
            }
        } else {
            FRESH_IDS(); WSB(ws);
            const float* modl = (const float*)(ws + WS_MODV) + (size_t)l * 9 * 6144; const bf16_t* XW = (const bf16_t*)(ws + WS_X); bf16_t* HB = (bf16_t*)(ws + WS_H); const float* g_attn = INP(I_GATTN) + l * DM;
            const int gwl = ((int)blockIdx.x - 32) * NWAVES + wave, NGL = (G - 32) * NWAVES;
#define P1_ROW(t_) ((size_t)((t_) / SEQ) * TROWS + CTX + ((t_) % SEQ))
            f32x4 nv[4]; if (gwl < NTOK) row_load(nv, XW + P1_ROW(gwl) * DM, lane);
            for (int tk = gwl; tk < NTOK; tk += NGL) {
                const int b = tk / SEQ; const size_t r = P1_ROW(tk);
                f32x4 v[4];
#pragma unroll
                for (int q = 0; q < 4; ++q) v[q] = nv[q];
                if (tk + NGL < NTOK) row_load(nv, XW + P1_ROW(tk + NGL) * DM, lane);
                const float* mr = modl + (size_t)b * 6144;
                f32x4 hv[4]; normmod_row(v, g_attn, mr, mr + DM, HB + r * DM, lane, hv);
            }
#undef P1_ROW
        }
        GRID_BAR();
        {
            WSB(ws);
            pg8::Gemm g{(const bf16_t*)(ws + WS_H), (const bf16_t*)(ws + WS_WIN) + (size_t)l * 2048 * DM, DM, DM}; pg8::MapOrder<0> S; S.so.init(MROWS / 256, 7, G, (int)blockIdx.x);
            LAS float* bslot = (LAS float*)(lds + LDSCTL_OFF + 1024);
            { int t0_ = threadIdx.x; asm volatile("" : "+v"(t0_)); if (t0_ < 32) bslot[t0_] = 0.f; }
            __syncthreads();
            pg8::EpiIn E{(bf16_t*)(ws + WS_P), (float*)(ws + WS_MS), (const f32x2*)(ws + WS_ROPEA), (const f32x2*)(ws + WS_ROPEB), INP(I_GQ) + l * 64, INP(I_GK) + l * 64, bslot, (bf16_t*)(ws + WS_KTG)};
            pg8::gemm_phase<pg8::EpiIn, pg8::MapOrder<0>, true>(lds, g, S, E);
            { pg8::TailOrder T; T.init(MROWS / 256, 7, G, (int)blockIdx.x, (MROWS / 256) * 7); pg8::gemm_phase<pg8::EpiIn, pg8::TailOrder, true, 2, true>(lds, g, T, E); }
            __syncthreads();
            { int t1_ = threadIdx.x; asm volatile("" : "+v"(t1_)); if (t1_ < 3) { float m = 0.f; for (int w = 0; w < NWAVES; ++w) m = fmaxf(m, bslot[w * 4 + t1_]); ((float*)(ws + WS_BND))[((size_t)l * 1024 + blockIdx.x) * 8 + t1_] = m; } }
            __syncthreads();
        }
        GRID_BAR();
        {
            WSB(ws);
            pg8::Gemm gq{(const bf16_t*)(ws + WS_P) + 1536, (const bf16_t*)(ws + WS_WU) + (size_t)l * 512 * 256, PW, 256}; pg8::Gemm gkv{(const bf16_t*)(ws + WS_P) + 1664, (const bf16_t*)(ws + WS_WUKV) + (size_t)l * 512 * 256, PW, 256};
            LAS float* bslot = (LAS float*)(lds + LDSCTL_OFF + 1024);
            if (threadIdx.x < 16) bslot[threadIdx.x] = 0.f;
            __syncthreads();
            pg8::EpiMla Eq{(bf16_t*)(ws + WS_QM), (bf16_t*)(ws + WS_KN), (bf16_t*)(ws + WS_VM), (const float*)(ws + WS_MS), bslot, 0, 384};
            pg8::EpiMla Ekv{(bf16_t*)(ws + WS_QM), (bf16_t*)(ws + WS_KN), (bf16_t*)(ws + WS_VM), (const float*)(ws + WS_MS), bslot, 384, 896};
            constexpr int NMT = MROWS / 256;
            { pg8::RotOrder S; S.init(NMT, 1, 0, G, (int)blockIdx.x, 0); pg8::gemm_phase<pg8::EpiMla, pg8::RotOrder, true>(lds, gq, S, Eq); }
            { pg8::RotOrder S; S.init(NMT, 2, 0, G, (int)blockIdx.x, NMT % G); pg8::gemm_phase<pg8::EpiMla, pg8::RotOrder, true>(lds, gkv, S, Ekv); }
            { pg8::RotOrder S; S.init(NMT, 1, 1, G, (int)blockIdx.x, (3 * NMT) % G); pg8::gemm_phase<pg8::EpiMla, pg8::RotOrder, true, 2, true>(lds, gq, S, Eq); }
            __syncthreads();
            if (threadIdx.x < 2) { float m = 0.f; for (int w = 0; w < NWAVES; ++w) m = fmaxf(m, bslot[w * 2 + threadIdx.x]); ((float*)(ws + WS_BND))[((size_t)l * 1024 + blockIdx.x) * 8 + 3 + threadIdx.x] = m; }
        }
        GRID_BAR();
        {
            WSB(ws);
            bf16_t* PB = (bf16_t*)(ws + WS_P); bf16_t* HB = (bf16_t*)(ws + WS_H); bf16_t* QM = (bf16_t*)(ws + WS_QM); bf16_t* KN = (bf16_t*)(ws + WS_KN); bf16_t* VM = (bf16_t*)(ws + WS_VM); const bf16_t* KTG = (const bf16_t*)(ws + WS_KTG);
            const float lam = ((const float*)(ws + WS_LAM))[l]; const float oml = 1.0f - (l == 0 ? 0.2f : 0.35550906759096934f); const float* d_gsub = INP(I_GSUB) + l * 64;
            const int per_b = 256 + (l == 0 ? 16 : 0), nrd = (per_b + 31) / 32, total = nrd * 256;
            bool gqa_nomax;
            { const float* gq_ = INP(I_GQ) + l * 64; const float* gk_ = INP(I_GK) + l * 64; float mq = 0.f, mk = 0.f;
              for (int i = 0; i < 64; ++i) { mq = fmaxf(mq, fabsf(gq_[i])); mk = fmaxf(mk, fabsf(gk_[i])); }
              gqa_nomax = __builtin_amdgcn_readfirstlane((int)(64.0f * SC_G * mq * mk < 60.0f)) != 0; }
            bool dif_nomax, mla_nomax;
            { FRESH_IDS(); const float* bnd = (const float*)(ws + WS_BND) + (size_t)l * 1024 * 8; float m[5] = {0.f, 0.f, 0.f, 0.f, 0.f};
              for (int w = tid; w < G; w += NWAVES * 64) {
#pragma unroll
                  for (int k = 0; k < 5; ++k) m[k] = fmaxf(m[k], bnd[(size_t)w * 8 + k]); }
              LAS float* red = (LAS float*)lds;
#pragma unroll
              for (int k = 0; k < 5; ++k) { const float v = wave_max(m[k]); if (lane == 0) red[wave * 8 + k] = v; }
              __syncthreads();
              float t[5];
#pragma unroll
              for (int k = 0; k < 5; ++k) { float v = 0.f; for (int w = 0; w < NWAVES; ++w) v = fmaxf(v, red[w * 8 + k]); t[k] = v; }
              __syncthreads();
              const float bd = sqrtf(t[0] * t[1]) * 1.02f, bm = sqrtf(3.0f * t[3] * (2.0f * t[4] + t[2])) * 1.02f;
              dif_nomax = __builtin_amdgcn_readfirstlane((int)(bd < 90.0f)) != 0; mla_nomax = __builtin_amdgcn_readfirstlane((int)(bm < 90.0f)) != 0; }
            for (int U = vcu; U < total; U += G) {
                const int cl = U % 32, xb = (U / 32) % NB, rd = U / 256;
                const int jj = rd * 32 + cl; if (jj >= per_b) continue;
                int kind, hd, qb;
                if (jj < 128) { kind = 0; hd = jj >> 4; qb = (jj & 15) + 1; } else if (jj < 192) { kind = 1; hd = (jj - 128) >> 4; qb = (jj & 15) + 1; } else if (jj < 256) { kind = 2; hd = (jj - 192) >> 4; qb = (jj & 15) + 1; }
                else { const int c = jj - 256; qb = 0; if (c < 8) { kind = 0; hd = c; } else if (c < 12) { kind = 1; hd = c - 8; } else { kind = 2; hd = c - 12; } }
                const size_t rb = (size_t)xb * TROWS, rq = rb + (size_t)qb * 256;
                const int NT = qb == 0 ? CTX / 64 : TROWS / 64;
                if (kind == 0) {
                    if (gqa_nomax) attn_body::attn_unit<8, 0, 0, 64, true, 128, true>((const attn_body::bf16*)(PB + rq * PW + (hd >> 2) * 256 + (hd & 3) * 32), PW, (const attn_body::bf16*)(KTG + ((size_t)(hd >> 2) * (MROWS / 64) + rb / 64) * 4096), PW, (const attn_body::bf16*)(PB + rb * PW + 576 + (hd >> 2) * 32), PW, (attn_body::bf16*)(HB + rq * DM + hd * 64), DM, NT, (char*)lds, 0.f, 0.f, d_gsub);
                    else attn_body::attn_unit<8, 0, 0, 64, false, 128, true>((const attn_body::bf16*)(PB + rq * PW + (hd >> 2) * 256 + (hd & 3) * 32), PW, (const attn_body::bf16*)(KTG + ((size_t)(hd >> 2) * (MROWS / 64) + rb / 64) * 4096), PW, (const attn_body::bf16*)(PB + rb * PW + 576 + (hd >> 2) * 32), PW, (attn_body::bf16*)(HB + rq * DM + hd * 64), DM, NT, (char*)lds, 0.f, 0.f, d_gsub); }
                else if (kind == 1) {
                    if (dif_nomax) { attn_body::attn_unit<8, 1, 1, 64, true>((const attn_body::bf16*)(PB + rq * PW + PC_DQ + hd * 64), PW, (const attn_body::bf16*)(PB + rb * PW + PC_DK + hd * 64), PW, (const attn_body::bf16*)(PB + rb * PW + PC_DV + hd * 64), PW, (attn_body::bf16*)(HB + rq * DM + 512 + hd * 64), DM, NT, (char*)lds, lam, oml, d_gsub);
                                     attn_body::attn_unit<8, 2, 2, 64, true>((const attn_body::bf16*)(PB + rq * PW + PC_DQ + hd * 64), PW, (const attn_body::bf16*)(PB + rb * PW + PC_DK + hd * 64), PW, (const attn_body::bf16*)(PB + rb * PW + PC_DV + hd * 64), PW, (attn_body::bf16*)(HB + rq * DM + 512 + hd * 64), DM, NT, (char*)lds, lam, oml, d_gsub); }
                    else { attn_body::attn_unit<8, 1, 1>((const attn_body::bf16*)(PB + rq * PW + PC_DQ + hd * 64), PW, (const attn_body::bf16*)(PB + rb * PW + PC_DK + hd * 64), PW, (const attn_body::bf16*)(PB + rb * PW + PC_DV + hd * 64), PW, (attn_body::bf16*)(HB + rq * DM + 512 + hd * 64), DM, NT, (char*)lds, lam, oml, d_gsub);
                           attn_body::attn_unit<8, 2, 2>((const attn_body::bf16*)(PB + rq * PW + PC_DQ + hd * 64), PW, (const attn_body::bf16*)(PB + rb * PW + PC_DK + hd * 64), PW, (const attn_body::bf16*)(PB + rb * PW + PC_DV + hd * 64), PW, (attn_body::bf16*)(HB + rq * DM + 512 + hd * 64), DM, NT, (char*)lds, lam, oml, d_gsub); } }
                else {
                    if (mla_nomax) attn_body::attn_unit<8, 0, 0, 96, true>((const attn_body::bf16*)(QM + rq * 384 + hd * 96), 384, (const attn_body::bf16*)(KN + rb * 256 + hd * 64), 256, (const attn_body::bf16*)(VM + rb * 256 + hd * 64), 256, (attn_body::bf16*)(HB + rq * DM + 768 + hd * 64), DM, NT, (char*)lds, 0.f, 0.f, d_gsub,
                        (const attn_body::bf16*)(PB + rb * PW + PC_KR), PW, (const attn_body::f32x2_t*)(ws + WS_ROPEB), qb == 0 ? -1 : (qb - 1) * 256);
                    else attn_body::attn_unit<8, 0, 0, 96>((const attn_body::bf16*)(QM + rq * 384 + hd * 96), 384, (const attn_body::bf16*)(KN + rb * 256 + hd * 64), 256, (const attn_body::bf16*)(VM + rb * 256 + hd * 64), 256, (attn_body::bf16*)(HB + rq * DM + 768 + hd * 64), DM, NT, (char*)lds, 0.f, 0.f, d_gsub,
                        (const attn_body::bf16*)(PB + rb * PW + PC_KR), PW, (const attn_body::f32x2_t*)(ws + WS_ROPEB), qb == 0 ? -1 : (qb - 1) * 256); }
            }
        }
        GRID_BAR();
        if (l == 0) {
            WSB(ws);
            pg8::Gemm g{(const bf16_t*)(ws + WS_H), (const bf16_t*)(ws + WS_WOUT), DM, DM}; pg8::MapOrder<1> S; S.so.init(NTOK / 256, 4, G, (int)blockIdx.x);
            pg8::EpiRes<false> E{INP(I_X), INP(I_CTX), (bf16_t*)(ws + WS_X), (const float*)(ws + WS_MODV), 2, 1.0f, 1};
            pg8::gemm_phase<pg8::EpiRes<false>, pg8::MapOrder<1>, true>(lds, g, S, E);
        } else {
            WSB(ws);
            pg8::Gemm g{(const bf16_t*)(ws + WS_H), (const bf16_t*)(ws + WS_WOUT) + (size_t)DM * DM, DM, DM}; pg8::MapOrder<1> S; S.so.init(NTOK / 256, 4, G, (int)blockIdx.x);
            pg8::EpiRes<true> E{nullptr, nullptr, (bf16_t*)(ws + WS_X), (const float*)(ws + WS_MODV) + (size_t)9 * 6144, 2, 1.0f, 1};
            pg8::gemm_phase<pg8::EpiRes<true>, pg8::MapOrder<1>, true>(lds, g, S, E);
        }
        GRID_BAR();
        if (l == 0) {
            if ((int)blockIdx.x < 32) {
                const int c = (int)blockIdx.x, b = c & 7, pn = c >> 3;
                {
                    WSB(ws);
                    pg8::Gemm g{(const bf16_t*)(ws + WS_H), (const bf16_t*)(ws + WS_WOUT), DM, DM}; pg8::CtxOrder S{c, TPB};
                    pg8::EpiRes<false> E{INP(I_X), INP(I_CTX), (bf16_t*)(ws + WS_X), (const float*)(ws + WS_MODV), 2, 1.0f, 1};
                    pg8::gemm_phase<pg8::EpiRes<false>, pg8::CtxOrder, true>(lds, g, S, E);
                }
                { WSB(ws); ctx_handoff((unsigned*)(ws + WS_CTL), b); }
                {
                    FRESH_IDS(); WSB(ws);
                    const float* mr = (const float*)(ws + WS_MODV) + (size_t)8 * 6144; const bf16_t* XW = (const bf16_t*)(ws + WS_X); const float* g_ffn = INP(I_GFFN);
                    const int j0 = 64 * pn + wave * 8; const size_t r0 = (size_t)b * TROWS + j0;
                    f32x4 nv[4]; row_load(nv, XW + r0 * DM, lane);
                    for (int i = 0; i < 8; ++i) {
                        f32x4 v[4];
#pragma unroll
                        for (int q = 0; q < 4; ++q) v[q] = nv[q];
                        if (i + 1 < 8) row_load(nv, XW + (r0 + i + 1) * DM, lane);
                        f32x4 hv[4]; normmod_row<true>(v, g_ffn, mr + 3 * DM, mr + 4 * DM, (unsigned char*)(ws + WS_H8) + ((size_t)b * CTX + j0 + i) * DM, lane, hv);
                    }
                }
            } else {
                FRESH_IDS(); WSB(ws);
                const float* modl = (const float*)(ws + WS_MODV); const bf16_t* XW = (const bf16_t*)(ws + WS_X); const float* g_ffn = INP(I_GFFN);
                const int gwl = ((int)blockIdx.x - 32) * NWAVES + wave, NGL = (G - 32) * NWAVES;
#define P8_ROW(t_) ((size_t)((t_) / SEQ) * TROWS + CTX + ((t_) % SEQ))
                f32x4 nv[4]; if (gwl < NTOK) row_load(nv, XW + P8_ROW(gwl) * DM, lane);
                for (int tk = gwl; tk < NTOK; tk += NGL) {
                    const int b = tk / SEQ; const size_t r = P8_ROW(tk); const float* mr = modl + (size_t)b * 6144;
                    f32x4 v[4];
#pragma unroll
                    for (int q = 0; q < 4; ++q) v[q] = nv[q];
                    if (tk + NGL < NTOK) row_load(nv, XW + P8_ROW(tk + NGL) * DM, lane);
                    f32x4 hv[4]; normmod_row<true>(v, g_ffn, mr + 3 * DM, mr + 4 * DM, (unsigned char*)(ws + WS_QM) + r * DM, lane, hv);
                }
#undef P8_ROW
            }
            GRID_BAR();
            {
                WSB(ws);
                {
                    pg8::Gemm g{(const bf16_t*)(ws + WS_QM), (const bf16_t*)(ws + WS_FIN8), DM, DM}; pg8::MapOrder<1> S; S.so.init(NTOK / 256, 22, G, (int)blockIdx.x);
                    pg8::EpiSwiglu<false, true> E{(void*)(ws + WS_ACT), DFF, 22, 0};
                    pg8::gemm_phase<pg8::EpiSwiglu<false, true>, pg8::MapOrder<1>, true, 1>(lds, g, S, E);
                }
                {
                    pg8::Gemm g{(const bf16_t*)(ws + WS_H8), (const bf16_t*)(ws + WS_FIN8), DM, DM}; pg8::MapOrder<0> S; S.so.init(NB, 22, G, (int)blockIdx.x);
                    pg8::EpiSwiglu<true> E{(void*)(ws + WS_ACT8), DFF, 22, 0};
                    pg8::gemm_phase<pg8::EpiSwiglu<true>, pg8::MapOrder<0>, true, 1>(lds, g, S, E);
                }
            }
            GRID_BAR();
            {
                WSB(ws);
                {
                    pg8::Gemm g{(const bf16_t*)(ws + WS_ACT), (const bf16_t*)(ws + WS_FOUT), DFF, DFF}; pg8::MapOrder<1> S; S.so.init(NTOK / 256, 4, G, (int)blockIdx.x);
                    pg8::EpiRes<true> E{nullptr, nullptr, (bf16_t*)(ws + WS_X), (const float*)(ws + WS_MODV), 5, 1.0f, 1};
                    pg8::gemm_phase<pg8::EpiRes<true>, pg8::MapOrder<1>, true>(lds, g, S, E);
                }
            }
            GRID_BAR();
        } else {
            {
                FRESH_IDS(); WSB(ws);
                const float* modl = (const float*)(ws + WS_MODV) + (size_t)9 * 6144; const bf16_t* XW = (const bf16_t*)(ws + WS_X); bf16_t* HB = (bf16_t*)(ws + WS_H);
                int* tok_e = (int*)(ws + WS_TOKE); float* tok_w = (float*)(ws + WS_TOKW); unsigned* ctl = (unsigned*)(ws + WS_CTL);
                const float* g_ffn = INP(I_GFFN) + DM; const float* moe_router = INP(I_ROUTER);
                LAS float* wrT = (LAS float*)lds;
                LAS unsigned* hist = (LAS unsigned*)(lds + 32768);
                for (int i = tid; i < NEXP * DM; i += NWAVES * 64) { const int e = i / DM, k = i % DM; wrT[i] = moe_router[k * NEXP + e]; }
                if (tid < NEXP) hist[tid] = 0u;
                __syncthreads();
#define TK_ROW(t_) ((size_t)((t_) / SEQ) * TROWS + CTX + ((t_) % SEQ))
                f32x4 nv[4]; if (gw < NTOK) row_load(nv, XW + TK_ROW(gw) * DM, lane);
                for (int tk = gw; tk < NTOK; tk += NGW) {
                    const int b = tk / SEQ; const size_t r = TK_ROW(tk); const float* mr = modl + (size_t)b * 6144;
                    f32x4 v[4];
#pragma unroll
                    for (int q = 0; q < 4; ++q) v[q] = nv[q];
                    if (tk + NGW < NTOK) row_load(nv, XW + TK_ROW(tk + NGW) * DM, lane);
                    f32x4 hv[4]; normmod_row<true>(v, g_ffn, mr + 3 * DM, mr + 4 * DM, (unsigned char*)HB + r * DM, lane, hv);
                    float lg[NEXP];
#pragma unroll
                    for (int e = 0; e < NEXP; ++e) { float sacc = 0.f;
#pragma unroll
                        for (int j = 0; j < 4; ++j) { const f32x4 w = ((const LAS f32x4*)(wrT + e * DM))[lane + 64 * j]; sacc += (hv[j].x * w.x + hv[j].y * w.y) + (hv[j].z * w.z + hv[j].w * w.w); }
                        lg[e] = wave_sum(sacc); }
                    int e0 = 0; float v0 = lg[0];
#pragma unroll
                    for (int e = 1; e < NEXP; ++e) if (lg[e] > v0) { v0 = lg[e]; e0 = e; }
                    int e1 = -1; float v1 = -3.0e38f;
#pragma unroll
                    for (int e = 0; e < NEXP; ++e) if (e != e0 && lg[e] > v1) { v1 = lg[e]; e1 = e; }
                    if (lane == 0) { const float w1 = 1.0f / (1.0f + expf(v0 - v1)); tok_e[2 * tk] = e0; tok_e[2 * tk + 1] = e1; tok_w[2 * tk] = 1.0f - w1; tok_w[2 * tk + 1] = w1;
                        __hip_atomic_fetch_add(&hist[e0], 1u, __ATOMIC_RELAXED, __HIP_MEMORY_SCOPE_WORKGROUP); __hip_atomic_fetch_add(&hist[e1], 1u, __ATOMIC_RELAXED, __HIP_MEMORY_SCOPE_WORKGROUP); }
                }
                __syncthreads();
                if (tid < NEXP && hist[tid]) atomicAdd(ctl + CW_CNT + 64 * tid, hist[tid]);
                __syncthreads();
                const float* moe_w_in = INP(I_MWIN); const float* moe_w_out = INP(I_MWOUT); bf16_t* Min_t = (bf16_t*)(ws + WS_MIN); bf16_t* Mout_t = (bf16_t*)(ws + WS_MOUT);
                LAS float* scr = (LAS float*)(lds + wave * 16384);
                constexpr int N_MIN = 16 * 112, N_MOUT = 28 * 32;
                for (int it = gw; it < NEXP * (N_MIN + N_MOUT); it += NGW) {
                    const int e = it / (N_MIN + N_MOUT), r = it % (N_MIN + N_MOUT);
                    if (r < N_MIN) transpose_item<true>(moe_w_in + (size_t)e * DM * 2 * DFE, DM, 2 * DFE, (unsigned char*)Min_t + (size_t)e * 2 * DFE * DM, 1, DFE, scr, r, lane);
                    else transpose_item<true>(moe_w_out + (size_t)e * DFE * DM, DFE, DM, (unsigned char*)Mout_t + (size_t)e * DM * DFE, 0, 0, scr, r - N_MIN, lane);
                }
            }
            GRID_BAR();
            int ntiles;
            {
                FRESH_IDS(); WSB(ws);
                unsigned* ctl = (unsigned*)(ws + WS_CTL); const int* tok_e = (const int*)(ws + WS_TOKE); int* tok_s = (int*)(ws + WS_TOKS); int* tile_e = (int*)(ws + WS_TILEE);
                const bf16_t* HB = (const bf16_t*)(ws + WS_H); unsigned char* AMOE8 = (unsigned char*)(ws + WS_AMOE8);
                LAS unsigned* lcnt = (LAS unsigned*)lds; LAS unsigned* lbase = lcnt + 8; LAS int* lsrc = (LAS int*)(lds + 64); LAS int* ldst = (LAS int*)(lds + 64 + 1024);
                unsigned cnt[NEXP], segb[NEXP]; unsigned accb = 0;
#pragma unroll
                for (int e = 0; e < NEXP; ++e) { cnt[e] = xb_ld(ctl + CW_CNT + 64 * e); segb[e] = accb; accb += ((cnt[e] + 255u) / 256u) * 256u; }
                ntiles = __builtin_amdgcn_readfirstlane((int)(accb / 256u));
                if (blockIdx.x == 0) { for (int ti = tid; ti < ntiles; ti += NWAVES * 64) { int e = 0;
#pragma unroll
                        for (int q = 1; q < NEXP; ++q) if ((unsigned)ti * 256u >= segb[q]) e = q;
                        tile_e[ti] = e; } }
                for (int chunk = vcu; chunk < NTOK / 128; chunk += G) {
                    if (tid < NEXP) lcnt[tid] = 0u;
                    __syncthreads();
                    int e = 0, tk = 0, kk = 0; unsigned pos = 0;
                    if (tid < 256) { tk = chunk * 128 + (tid >> 1); kk = tid & 1; e = tok_e[2 * tk + kk]; pos = __hip_atomic_fetch_add(&lcnt[e], 1u, __ATOMIC_RELAXED, __HIP_MEMORY_SCOPE_WORKGROUP); }
                    __syncthreads();
                    if (tid < NEXP) lbase[tid] = lcnt[tid] ? atomicAdd(ctl + CW_FILL + 64 * tid, lcnt[tid]) : 0u;
                    __syncthreads();
                    if (tid < 256) { unsigned sb = 0;
#pragma unroll
                        for (int q = 0; q < NEXP; ++q) sb = (e == q) ? segb[q] : sb;
                        const int slot = (int)(sb + lbase[e] + pos); tok_s[2 * tk + kk] = slot; ldst[tid] = slot; const int b = tk / SEQ, s = tk % SEQ; lsrc[tid] = b * TROWS + CTX + s; }
                    __syncthreads();
                    for (int i0 = wave * 32; i0 < wave * 32 + 32; i0 += 16) { u32x4 va[16];
#pragma unroll
                        for (int q = 0; q < 16; ++q) { const u32x4* sp = (const u32x4*)((const unsigned char*)HB + (size_t)lsrc[i0 + q] * DM); va[q] = __builtin_nontemporal_load(sp + lane); }
#pragma unroll
                        for (int q = 0; q < 16; ++q) { u32x4* dp = (u32x4*)((unsigned char*)AMOE8 + (size_t)ldst[i0 + q] * DM); dp[lane] = va[q]; } }
                    __syncthreads();
                }
            }
            GRID_BAR();
            {
                const int t0 = 0; const int nt_c = ntiles;
                {
                    WSB(ws);
                    pg8::Gemm g{(const bf16_t*)(ws + WS_AMOE8), (const bf16_t*)(ws + WS_MIN), DM, DM}; pg8::MapOrder<2> S; S.so.init(nt_c, 14, G, (int)blockIdx.x); S.t0 = t0; S.nct = 14; S.tile_e = (const int*)(ws + WS_TILEE);
                    pg8::EpiSwiglu<true> E{(void*)(ws + WS_ACTC), DFE, 14, t0};
                    pg8::gemm_phase<pg8::EpiSwiglu<true>, pg8::MapOrder<2>, true, 1>(lds, g, S, E);
                }
                GRID_BAR();
                {
                    WSB(ws);
                    const int ntot = nt_c * 4, nfull_ = (ntot / G) * G, nfull = (2 * (ntot - nfull_) <= G) ? nfull_ : ntot;
                    pg8::Gemm g{(const bf16_t*)(ws + WS_ACTC), (const bf16_t*)(ws + WS_MOUT), DFE, DFE}; pg8::MapOrder<3> S; S.so.init(nt_c, 4, G, (int)blockIdx.x); S.so.nwg = nfull; S.t0 = t0; S.nct = 4; S.tile_e = (const int*)(ws + WS_TILEE);
                    pg8::EpiBf16 E{(bf16_t*)(ws + WS_AMOE), DM, DM, 4, t0, W8_INV};
                    pg8::gemm_phase<pg8::EpiBf16, pg8::MapOrder<3>, true, 1>(lds, g, S, E);
                    if (nfull < ntot) {
                        pg8::MoeTailOrder T; T.so.init(nt_c, 4, G, (int)blockIdx.x); T.nfull = nfull; T.ntot = ntot; T.c = (int)blockIdx.x; T.nct = 4; T.tile_e = (const int*)(ws + WS_TILEE);
                        pg8::EpiBf16H EH{(bf16_t*)(ws + WS_AMOE), DM, 4, t0, W8_INV};
                        pg8::gemm_phase<pg8::EpiBf16H, pg8::MoeTailOrder, true, 1, true>(lds, g, T, EH);
                    }
                }
                GRID_BAR();
            }
            {
                FRESH_IDS(); WSB(ws);
                const float* modl = (const float*)(ws + WS_MODV) + (size_t)9 * 6144; const bf16_t* XW = (const bf16_t*)(ws + WS_X); const bf16_t* AMOE = (const bf16_t*)(ws + WS_AMOE);
                const int* tok_s = (const int*)(ws + WS_TOKS); const float* tok_w = (const float*)(ws + WS_TOKW); const float* g_final = INP(I_GFINAL);
                GAS float* outp = (GAS float*)outbase; asm volatile("" : "+s"(outp));
                f32x4 nv[4]; u32x2 nya[4], nyc[4]; float nw0 = 0.f, nw1 = 0.f; int ps0 = 0, ps1 = 0; float pw0 = 0.f, pw1 = 0.f;
#define FIN_LOADY(t_s0, t_s1) do { const u32x2* y0_ = (const u32x2*)(AMOE + (size_t)(t_s0) * DM) + lane; const u32x2* y1_ = (const u32x2*)(AMOE + (size_t)(t_s1) * DM) + lane; \
        _Pragma("unroll") for (int j = 0; j < 4; ++j) { nya[j] = __builtin_nontemporal_load(y0_ + 64 * j); nyc[j] = __builtin_nontemporal_load(y1_ + 64 * j); } } while (0)
                if (gw < NTOK) { row_load(nv, XW + TK_ROW(gw) * DM, lane); const int s0 = tok_s[2 * gw], s1 = tok_s[2 * gw + 1]; nw0 = tok_w[2 * gw]; nw1 = tok_w[2 * gw + 1]; FIN_LOADY(s0, s1); }
                if (gw + NGW < NTOK) { const int tn = gw + NGW; ps0 = tok_s[2 * tn]; ps1 = tok_s[2 * tn + 1]; pw0 = tok_w[2 * tn]; pw1 = tok_w[2 * tn + 1]; }
                for (int tk = gw; tk < NTOK; tk += NGW) {
                    const int b = tk / SEQ; const float* gate = modl + (size_t)b * 6144 + 5 * DM;
                    const float w0 = nw0, w1 = nw1;
                    f32x4 xq[4]; u32x2 ya_[4], yc_[4];
#pragma unroll
                    for (int q = 0; q < 4; ++q) { xq[q] = nv[q]; ya_[q] = nya[q]; yc_[q] = nyc[q]; }
                    if (tk + NGW < NTOK) { const int tn = tk + NGW; row_load(nv, XW + TK_ROW(tn) * DM, lane); FIN_LOADY(ps0, ps1); nw0 = pw0; nw1 = pw1; }
                    if (tk + 2 * NGW < NTOK) { const int t2 = tk + 2 * NGW; ps0 = tok_s[2 * t2]; ps1 = tok_s[2 * t2 + 1]; pw0 = tok_w[2 * t2]; pw1 = tok_w[2 * t2 + 1]; }
                    f32x4 v[4]; float ss = 0.f;
#pragma unroll
                    for (int j = 0; j < 4; ++j) { const f32x4 xv = xq[j]; const u32x2 a = ya_[j], c = yc_[j]; const f32x4 gv = ((const f32x4*)gate)[lane + 64 * j];
                        const f32x4 ya = (f32x4){bflo(a.x), bfhi(a.x), bflo(a.y), bfhi(a.y)}, yc = (f32x4){bflo(c.x), bfhi(c.x), bflo(c.y), bfhi(c.y)};
                        v[j] = xv + gv * (ya * w0 + yc * w1); ss += (v[j].x * v[j].x + v[j].y * v[j].y) + (v[j].z * v[j].z + v[j].w * v[j].w); }
                    const float rstd = 1.0f / sqrtf(wave_sum(ss) * (1.f / DM) + NEPS);
                    f32x4* orow = (f32x4*)(outp + (size_t)tk * DM) + lane;
#pragma unroll
                    for (int j = 0; j < 4; ++j) __builtin_nontemporal_store(v[j] * rstd * ((const f32x4*)g_final)[lane + 64 * j], orow + 64 * j);
                }
#undef FIN_LOADY
            }
        }
}

__global__ void __launch_bounds__(NWAVES * 64, 2) fwd_kernel(Args args) {
    extern __shared__ __attribute__((aligned(16))) unsigned char lds_raw[];
    LAS unsigned char* lds = (LAS unsigned char*)lds_raw;
    const int wave = __builtin_amdgcn_readfirstlane((int)threadIdx.x >> 6);
    const int G = gridDim.x; const int vcu = (G % 8 == 0) ? ((int)blockIdx.x % 8) * (G / 8) + (int)blockIdx.x / 8 : (int)blockIdx.x;
    const int gw = vcu * NWAVES + wave, NGW = G * NWAVES;
    unsigned char* const wsbase = args.ws;
    {
        FRESH_IDS();
        for (int u = tid; u < (LDS_BYTES - LDSCTL_OFF) / 4; u += NWAVES * 64) ((LAS unsigned*)(lds + LDSCTL_OFF))[u] = 0u;
        __syncthreads();
        if (tid < 27) { const unsigned long long p = (unsigned long long)args.in[tid]; LAS unsigned* t = (LAS unsigned*)(lds + PTR_OFF) + 2 * tid; t[0] = (unsigned)p; t[1] = (unsigned)(p >> 32); }
        __syncthreads();
        (void)xcd_barrier_post((unsigned*)(args.ws + WS_CTL) + CW_BAR, (volatile LAS unsigned*)(lds + MISC_OFF) + 8);
    }

    {
        FRESH_IDS(); WSB(ws);
        float* modv = (float*)(ws + WS_MODV); f32x2* ropeA = (f32x2*)(ws + WS_ROPEA); f32x2* ropeB = (f32x2*)(ws + WS_ROPEB); float* lamv = (float*)(ws + WS_LAM);
        bf16_t* Win_t = (bf16_t*)(ws + WS_WIN); bf16_t* Wout_t = (bf16_t*)(ws + WS_WOUT); bf16_t* Wu_t = (bf16_t*)(ws + WS_WU); bf16_t* Fout_t = (bf16_t*)(ws + WS_FOUT);
        {
            const float* c_in = INP(I_C); const float* cctx_in = INP(I_CCTX); const float* w_mod = INP(I_WMOD); const float* b_mod = INP(I_BMOD);
            LAS float* scs = (LAS float*)lds;
            LAS float* part = (LAS float*)(lds + 36864);
            for (int i = tid; i < 9 * DM; i += NWAVES * 64) { const int rt = i / DM, k = i % DM; const float c = rt < 8 ? c_in[rt * DM + k] : cctx_in[k]; scs[i] = c / (1.0f + __expf(-c)); }
            __syncthreads();
            for (int task = vcu; task < 192; task += G) {
                const int l = task / 96, nb = task % 96, n = nb * 64 + lane;
                const float* wp = w_mod + (size_t)l * DM * 6144 + n;
                float acc9[9];
#pragma unroll
                for (int r = 0; r < 9; ++r) acc9[r] = 0.f;
                for (int k0 = wave * 128; k0 < wave * 128 + 128; k0 += 32) { float w[32];
#pragma unroll
                    for (int u = 0; u < 32; ++u) w[u] = __builtin_nontemporal_load(wp + (size_t)(k0 + u) * 6144);
#pragma unroll
                    for (int u = 0; u < 32; ++u) {
#pragma unroll
                        for (int r = 0; r < 9; ++r) acc9[r] += scs[r * DM + k0 + u] * w[u];
                        if ((u & 3) == 3) asm volatile("" ::: "memory"); } }
#pragma unroll
                for (int r = 0; r < 9; ++r) part[(wave * 9 + r) * 64 + lane] = acc9[r];
                __syncthreads();
                for (int i = tid; i < 9 * 64; i += NWAVES * 64) { const int r = i / 64, c = i % 64; float s = 0.f;
#pragma unroll
                    for (int w = 0; w < 8; ++w) s += part[(w * 9 + r) * 64 + c];
                    modv[((size_t)l * 9 + r) * 6144 + nb * 64 + c] = s + b_mod[l * 6144 + nb * 64 + c]; }
                __syncthreads();
            }
            __syncthreads();
        }
        if (vcu == (G > 200 ? 200 : 0)) {
            const float ifA[16] = {1.000000000e+00f, 5.623413252e-01f, 3.162277660e-01f, 1.778279410e-01f, 1.000000000e-01f, 5.623413252e-02f, 3.162277660e-02f, 1.778279410e-02f, 1.000000000e-02f, 5.623413252e-03f, 3.162277660e-03f, 1.778279410e-03f, 1.000000000e-03f, 5.623413252e-04f, 3.162277660e-04f, 1.778279410e-04f};
            for (int i = tid; i < 64 * 16; i += NWAVES * 64) { const int pos = i >> 4, f = i & 15; float fr_ = 1.f;
#pragma unroll
                for (int q = 0; q < 16; ++q) fr_ = (f == q) ? ifA[q] : fr_;
                float sn, cs; sincos_small((float)pos * fr_, sn, cs); ropeA[i] = (f32x2){cs, sn}; }
            for (int i = tid; i < 64 * 8; i += NWAVES * 64) { const int pos = i >> 3, f = i & 7; float fr_ = 1.f;
#pragma unroll
                for (int q = 0; q < 8; ++q) fr_ = (f == q) ? ifA[2 * q] : fr_;
                float sn, cs; sincos_small((float)pos * fr_, sn, cs); ropeB[i] = (f32x2){cs, sn}; }
            if (wave == 0) {
                const float* d_lq1 = INP(I_LQ1); const float* d_lk1 = INP(I_LK1); const float* d_lq2 = INP(I_LQ2); const float* d_lk2 = INP(I_LK2);
                for (int l = 0; l < 2; ++l) {
                    float a = lane < 32 ? d_lq1[l * 32 + lane] * d_lk1[l * 32 + lane] : 0.f, b = lane < 32 ? d_lq2[l * 32 + lane] * d_lk2[l * 32 + lane] : 0.f;
                    a = wave_sum(a); b = wave_sum(b);
                    const float lam_init = l == 0 ? 0.2f : 0.35550906759096934f;
                    if (lane == 0) lamv[l] = expf(a) - expf(b) + lam_init;
                }
            }
        }
        {
            const float* w_in = INP(I_WIN); const float* w_out = INP(I_WOUT); const float* ffn_w_in = INP(I_FWIN); const float* ffn_w_out = INP(I_FWOUT);
            LAS float* scr = (LAS float*)(lds + wave * 16384);
            constexpr int N_WIN = 16 * 59, N_WOUT = 16 * 32, N_FIN = 16 * 176, N_FOUT = 44 * 32;
            constexpr int NITEMS = 2 * N_WIN + 2 * N_WOUT + N_FIN + 2 * N_FOUT;
            for (int it = gw; it < NITEMS; it += NGW) {
                int r = it;
                if (r < 2 * N_WIN) { const int l = r / N_WIN; transpose_item(w_in + (size_t)l * DM * INW, DM, INW, Win_t + (size_t)l * 2048 * DM, 2, 0, scr, r % N_WIN, lane); continue; } r -= 2 * N_WIN;
                if (r < 2 * N_WOUT) { const int l = r / N_WOUT; transpose_item(w_out + (size_t)l * DM * DM, DM, DM, Wout_t + (size_t)l * DM * DM, 0, 0, scr, r % N_WOUT, lane); continue; } r -= 2 * N_WOUT;
                if (r < N_FOUT) { transpose_item(ffn_w_out, DFF, DM, Fout_t, 0, 0, scr, r, lane); continue; } r -= N_FOUT;
                if (r < N_FIN) { transpose_item<true>(ffn_w_in, DM, 2 * DFF, (void*)(ws + WS_FIN8), 1, DFF, scr, r, lane); continue; } r -= N_FIN;
                transpose_item<true>(ffn_w_out, DFF, DM, (void*)(ws + WS_FOUT8), 0, 0, scr, r, lane);
            }
        }
        for (int i = vcu * 512 + tid; i < 2 * 20480; i += G * 512) { const int l = i / 20480, o = i % 20480; ((u32x4*)(Win_t + (size_t)l * 2048 * DM + (size_t)INW * DM))[o] = (u32x4){0u, 0u, 0u, 0u}; }
        {
            const float* m_wuq = INP(I_WUQ); const float* m_wukv = INP(I_WUKV); const float* m_gcq = INP(I_GCQ); const float* m_gckv = INP(I_GCKV);
            bf16_t* Wukv_t = (bf16_t*)(ws + WS_WUKV);
            for (int i = vcu * 512 + tid; i < 2 * 512 * 256; i += G * 512) { const int l = i / (512 * 256), rem = i % (512 * 256), n = rem / 256, k = rem % 256;
                float vq = 0.f, vkv = 0.f;
                if (n < 384 && k < 192) vq = m_wuq[((size_t)l * 192 + k) * 384 + n] * m_gcq[l * 192 + k];
                if (k >= 64 && k < 192) vkv = m_wukv[((size_t)l * 128 + (k - 64)) * 512 + n] * m_gckv[l * 128 + (k - 64)];
                Wu_t[i] = (bf16_t)(cvtpk(vq, 0.f) & 0xffffu); Wukv_t[i] = (bf16_t)(cvtpk(vkv, 0.f) & 0xffffu); }
        }
    }
    GRID_BAR();

    layer_body<0>(wsbase, args.out, lds, G, vcu, wave);
    layer_body<1>(wsbase, args.out, lds, G, vcu, wave);
}

extern "C" void kernel_launch(void* const* d_in, const int* in_sizes, int n_in, void* d_out, int out_size, void* d_ws, size_t ws_size, hipStream_t stream) {
    static int grid = 0;
    if (grid == 0) {
        if (n_in != 27 || out_size != NTOK * DM || ws_size < WS_END) { fprintf(stderr, "kernel_launch: unexpected sizes (n_in %d, out %d, ws %zu); nothing launched\n", n_in, out_size, ws_size); grid = -1; return; }
        int dev = 0, cus = 0, per_cu = 0;
        if (hipGetDevice(&dev) != hipSuccess || hipDeviceGetAttribute(&cus, hipDeviceAttributeMultiprocessorCount, dev) != hipSuccess) { grid = -1; return; }
        if (hipFuncSetAttribute((const void*)fwd_kernel, hipFuncAttributeMaxDynamicSharedMemorySize, LDS_BYTES) != hipSuccess) { grid = -1; return; }
        if (hipOccupancyMaxActiveBlocksPerMultiprocessor(&per_cu, (const void*)fwd_kernel, NWAVES * 64, LDS_BYTES) != hipSuccess || per_cu < 1)
            fprintf(stderr, "kernel_launch: occupancy query reports %d workgroups per CU\n", per_cu);
        (void)hipGetLastError();
        if (cus < 64) { fprintf(stderr, "kernel_launch: %d CUs (the context side chain needs 32 workgroups beside the others); nothing launched\n", cus); grid = -1; return; }
        grid = cus;
    }
    if (grid < 0) return;
    if (hipMemsetAsync((char*)d_ws + WS_CTL, 0, CTL_ZERO_BYTES, stream) != hipSuccess) return;
    Args a{};
    for (int i = 0; i < 27; ++i) a.in[i] = (const float*)d_in[i];
    a.out = (float*)d_out; a.ws = (unsigned char*)d_ws;
    hipLaunchKernelGGL(fwd_kernel, dim3(grid), dim3(NWAVES * 64), LDS_BYTES, stream, a);
}
```
